# Optimizing an MI355X kernel written in HIP

```python
import math
import jax, jax.numpy as jnp
from jax import lax
import numpy as np

D_MODEL = 1024
BATCH = 8
SEQ = 2048
DEPTH = 1
DEC_BATCH = 128
DEC_SEQ = 4
PAST_LEN = 16384
PAGE_SIZE = 128

MIX_WIDTH = D_MODEL
HG_WIDTH = MIX_WIDTH // 2
GD_WIDTH = MIX_WIDTH - HG_WIDTH
HG_HEAD_DIM = 128
HG_HEADS = HG_WIDTH // HG_HEAD_DIM
GD_HEAD_DIM = 128
GD_HEADS = GD_WIDTH // GD_HEAD_DIM
GD_CONV = 4
N_MEM = 256
MEM_HEADS = 4
MEM_HEAD_DIM = D_MODEL // MEM_HEADS
D_FF = 2816
FFN_CONV = 3
CHUNK = 64
LN_EPS = 1e-5
RMS_EPS = 1e-6
ALPHA = (2.0 * DEPTH) ** 0.25
BETA = (8.0 * DEPTH) ** -0.25
IN_COLS = 4 * HG_WIDTH + 4 * GD_WIDTH + 2 * GD_HEADS

kernel_name = "hymba_hgrn2_gdn_deepnorm_step"


def _layer_norm(x, g, b):
    xf = x.astype(jnp.float32)
    mu = jnp.mean(xf, -1, keepdims=True)
    var = jnp.mean(jnp.square(xf - mu), -1, keepdims=True)
    y = (xf - mu) * lax.rsqrt(var + LN_EPS) * g.astype(jnp.float32) + b.astype(jnp.float32)
    return y.astype(x.dtype)


def _rms_norm(x, g):
    xf = x.astype(jnp.float32)
    return xf * lax.rsqrt(jnp.mean(jnp.square(xf), -1, keepdims=True) + RMS_EPS) * g.astype(jnp.float32)


def _l2norm(x):
    xf = x.astype(jnp.float32)
    return xf * lax.rsqrt(jnp.sum(jnp.square(xf), -1, keepdims=True) + RMS_EPS)


def _causal_dwconv(x, buf, w):
    k_w = w.shape[0]
    t = x.shape[1]
    xp = jnp.concatenate([buf.astype(x.dtype), x], axis=1)
    out = sum(xp[:, j:j + t] * w[j].astype(x.dtype) for j in range(k_w))
    return out, xp[:, t:]


def _to_chunks(a, c):
    b, t, h, d = a.shape
    n = -(-t // c)
    a = jnp.pad(a.astype(jnp.float32), ((0, 0), (0, n * c - t), (0, 0), (0, 0)))
    return a.reshape(b, n, c, h, d).transpose(1, 0, 3, 2, 4)


def _from_chunks(o, t):
    n, b, h, c, d = o.shape
    return o.transpose(1, 0, 3, 2, 4).reshape(b, n * c, h, d)[:, :t]


def _hgrn2_chunked(q, k, v, log_f, s0):
    t = q.shape[1]
    c = min(CHUNK, t)
    qc, kc, vc, gc = (_to_chunks(a, c) for a in (q, k, v, log_f))
    incl = jnp.tril(jnp.ones((c, c), dtype=bool))[:, :, None]

    def step(s, inp):
        qi, ki, vi, gi = inp
        g_cum = jnp.cumsum(gi, axis=2)
        rel = jnp.where(incl, g_cum[:, :, :, None, :] - g_cum[:, :, None, :, :], -jnp.inf)
        scores = jnp.einsum('bhtd,bhsd,bhtsd->bhts', qi, ki, jnp.exp(rel))
        o = (jnp.einsum('bhts,bhsv->bhtv', scores, vi)
             + jnp.einsum('bhtd,bhdv->bhtv', qi * jnp.exp(g_cum), s))
        g_last = g_cum[:, :, -1:, :]
        s = (jnp.exp(g_last[:, :, 0, :])[..., None] * s
             + jnp.einsum('bhsd,bhsv->bhdv', ki * jnp.exp(g_last - g_cum), vi))
        return s, o

    s_fin, o = lax.scan(step, s0.astype(jnp.float32), (qc, kc, vc, gc))
    return _from_chunks(o, t), s_fin.astype(s0.dtype)


def _gdn_chunked(q, k, v, log_a, beta, s0):
    t = q.shape[1]
    c = min(CHUNK, t)
    qc, kc, vc, gc, bc = (_to_chunks(a, c) for a in (q, k, v, log_a, beta))
    incl = jnp.tril(jnp.ones((c, c), dtype=bool))
    strict = jnp.tril(jnp.ones((c, c), dtype=bool), -1)
    eye = jnp.eye(c, dtype=jnp.float32)

    def step(s, inp):
        qi, ki, vi, gi, bi = inp
        g_cum = jnp.cumsum(gi[..., 0], axis=-1)
        gamma = jnp.exp(g_cum)[..., None]
        decay = jnp.exp(jnp.where(incl, g_cum[..., :, None] - g_cum[..., None, :], -jnp.inf))
        a_mat = jnp.where(strict, bi * jnp.einsum('bhtd,bhsd->bhts', ki, ki) * decay, 0.0)
        rhs = bi * (vi - gamma * jnp.einsum('bhtd,bhdv->bhtv', ki, s))
        u = lax.linalg.triangular_solve(eye + a_mat, rhs, left_side=True, lower=True,
                                        unit_diagonal=True)
        o = (gamma * jnp.einsum('bhtd,bhdv->bhtv', qi, s)
             + jnp.einsum('bhts,bhsv->bhtv', jnp.einsum('bhtd,bhsd->bhts', qi, ki) * decay, u))
        g_last = g_cum[..., -1:]
        s = (jnp.exp(g_last)[..., None] * s
             + jnp.einsum('bhsd,bhsv->bhdv', ki * jnp.exp(g_last - g_cum)[..., None], u))
        return s, o

    s_fin, o = lax.scan(step, s0.astype(jnp.float32), (qc, kc, vc, gc, bc))
    return _from_chunks(o, t), s_fin.astype(s0.dtype)


def _mem_attn(h, mem_k, mem_v, w_mq, w_mo):
    bsz, t, _ = h.shape
    q = jnp.einsum('btd,de->bte', h, w_mq).reshape(bsz, t, MEM_HEADS, MEM_HEAD_DIM)
    s = jnp.einsum('bthd,bmhd->bhtm', q, mem_k.astype(h.dtype)).astype(jnp.float32) * MEM_HEAD_DIM ** -0.5
    p = jax.nn.softmax(s, axis=-1).astype(h.dtype)
    o = jnp.einsum('bhtm,bmhd->bthd', p, mem_v.astype(h.dtype)).reshape(bsz, t, D_MODEL)
    return jnp.einsum('btd,de->bte', o, w_mo)


def _conv_ffn(h, buf, w_up, w_conv, b_conv, w_down):
    up = jnp.einsum('btd,df->btf', h, w_up)
    gate, val = jnp.split(up, 2, axis=-1)
    gate_c, new_buf = _causal_dwconv(gate, buf, w_conv)
    act = jax.nn.gelu(gate_c + b_conv.astype(h.dtype), approximate=False) * val
    return jnp.einsum('btf,fd->btd', act, w_down), new_buf


def _layer(x, s_hg, s_gd, buf_gd, buf_ffn, mem_k, mem_v, lb,
           w_in, w_gd_conv, gd_a_log, gd_dt_bias, hg_norm_g, gd_norm_g, w_out,
           ln1_g, ln1_b, w_mq, w_mo, ln2_g, ln2_b,
           w_up, w_ffn_conv, b_ffn_conv, w_down, ln3_g, ln3_b):
    bsz, t, _ = x.shape
    f32 = jnp.float32
    proj = jnp.einsum('btd,de->bte', x, w_in)
    splits = np.cumsum([HG_WIDTH] * 4 + [3 * GD_WIDTH, GD_WIDTH, GD_HEADS]).tolist()
    hq, hf, hi, hgate, gqkv, gz, gb, ga = jnp.split(proj, splits, axis=-1)

    def heads(a, n_h):
        return a.reshape(bsz, t, n_h, -1)

    f = lb + (1.0 - lb) * jax.nn.sigmoid(hf.astype(f32))
    o_hg, new_hg = _hgrn2_chunked(heads(jax.nn.silu(hq), HG_HEADS), heads(1.0 - f, HG_HEADS),
                                  heads(hi, HG_HEADS), heads(jnp.log(f), HG_HEADS), s_hg)
    o_hg = (_rms_norm(o_hg, hg_norm_g) * jax.nn.silu(heads(hgate, HG_HEADS).astype(f32))
            ).reshape(bsz, t, HG_WIDTH)

    qkv, new_buf_gd = _causal_dwconv(gqkv, buf_gd, w_gd_conv)
    gq, gk, gv = jnp.split(jax.nn.silu(qkv), 3, axis=-1)
    q = _l2norm(heads(gq, GD_HEADS)) * GD_HEAD_DIM ** -0.5
    k = _l2norm(heads(gk, GD_HEADS))
    beta = jax.nn.sigmoid(gb.astype(f32))[..., None]
    log_a = (-jnp.exp(gd_a_log.astype(f32))
             * jax.nn.softplus(ga.astype(f32) + gd_dt_bias.astype(f32)))[..., None]
    o_gd, new_gd = _gdn_chunked(q, k, heads(gv, GD_HEADS), log_a, beta, s_gd)
    o_gd = (_rms_norm(o_gd, gd_norm_g) * jax.nn.silu(heads(gz, GD_HEADS).astype(f32))
            ).reshape(bsz, t, GD_WIDTH)

    mix = jnp.concatenate([o_hg, o_gd], axis=-1).astype(x.dtype)
    h = _layer_norm(ALPHA * x + jnp.einsum('btd,de->bte', mix, w_out), ln1_g, ln1_b)
    h = _layer_norm(ALPHA * h + _mem_attn(h, mem_k, mem_v, w_mq, w_mo), ln2_g, ln2_b)
    ff, new_buf_ffn = _conv_ffn(h, buf_ffn, w_up, w_ffn_conv, b_ffn_conv, w_down)
    y = _layer_norm(ALPHA * h + ff, ln3_g, ln3_b)
    return y, new_hg, new_gd, new_buf_gd, new_buf_ffn


def setup_inputs(seed: int = 0) -> dict:
    key = jax.random.key(seed)
    ks = iter(jax.random.split(key, 40))
    L, D = DEPTH, D_MODEL

    def nrm(shape, scale):
        return jax.random.normal(next(ks), shape, jnp.float32) * scale

    dt = jnp.exp(jax.random.uniform(next(ks), (L, GD_HEADS), jnp.float32,
                                    minval=math.log(1e-3), maxval=math.log(1e-1)))
    a_init = jax.random.uniform(next(ks), (L, GD_HEADS), jnp.float32, minval=1.0, maxval=16.0)
    return {
        "x_prompt": nrm((BATCH, SEQ, D), 1.0),
        "x_sample": nrm((DEC_BATCH, DEC_SEQ, D), 1.0),
        "state_hgrn": nrm((L, DEC_BATCH, HG_HEADS, HG_HEAD_DIM, HG_HEAD_DIM), 0.5),
        "state_gdn": nrm((L, DEC_BATCH, GD_HEADS, GD_HEAD_DIM, GD_HEAD_DIM), 0.3),
        "state_gdn_conv": nrm((L, DEC_BATCH, GD_CONV - 1, 3 * GD_WIDTH), 1.0),
        "state_ffn_conv": nrm((L, DEC_BATCH, FFN_CONV - 1, D_FF), 1.0),
        "cache_mem_k": nrm((L, DEC_BATCH, N_MEM, MEM_HEADS, MEM_HEAD_DIM), 1.0),
        "cache_mem_v": nrm((L, DEC_BATCH, N_MEM, MEM_HEADS, MEM_HEAD_DIM), 1.0),
        "mem_prompt": nrm((BATCH, N_MEM, D), 1.0),
        "hgrn_lb_logits": nrm((L + 1, HG_WIDTH), 0.5),
        "w_in": nrm((L, D, IN_COLS), D ** -0.5),
        "w_gd_conv": nrm((L, GD_CONV, 3 * GD_WIDTH), GD_CONV ** -0.5),
        "gd_a_log": jnp.log(a_init),
        "gd_dt_bias": dt + jnp.log(-jnp.expm1(-dt)),
        "hg_norm_g": 1.0 + nrm((L, HG_HEAD_DIM), 0.02),
        "gd_norm_g": 1.0 + nrm((L, GD_HEAD_DIM), 0.02),
        "w_out": nrm((L, MIX_WIDTH, D), MIX_WIDTH ** -0.5 * BETA),
        "ln1_g": 1.0 + nrm((L, D), 0.02),
        "ln1_b": nrm((L, D), 0.02),
        "w_mq": nrm((L, D, D), D ** -0.5),
        "w_mkv": nrm((L, D, 2 * D), D ** -0.5),
        "w_mo": nrm((L, D, D), D ** -0.5 * BETA),
        "ln2_g": 1.0 + nrm((L, D), 0.02),
        "ln2_b": nrm((L, D), 0.02),
        "w_up": nrm((L, D, 2 * D_FF), D ** -0.5),
        "w_ffn_conv": nrm((L, FFN_CONV, D_FF), FFN_CONV ** -0.5),
        "b_ffn_conv": nrm((L, D_FF), 0.02),
        "w_down": nrm((L, D_FF, D), D_FF ** -0.5 * BETA),
        "ln3_g": 1.0 + nrm((L, D), 0.02),
        "ln3_b": nrm((L, D), 0.02),
    }


def reference(x_prompt, x_sample, state_hgrn, state_gdn, state_gdn_conv, state_ffn_conv,
              cache_mem_k, cache_mem_v, mem_prompt, hgrn_lb_logits, w_in, w_gd_conv,
              gd_a_log, gd_dt_bias, hg_norm_g, gd_norm_g, w_out, ln1_g, ln1_b,
              w_mq, w_mkv, w_mo, ln2_g, ln2_b, w_up, w_ffn_conv, b_ffn_conv, w_down,
              ln3_g, ln3_b):
    bp = x_prompt.shape[0]
    dt_p = x_prompt.dtype
    lb_all = jnp.cumsum(jax.nn.softmax(hgrn_lb_logits.astype(jnp.float32), axis=0), axis=0)

    xp, xs = x_prompt, x_sample
    p_hg, p_gd, p_bgd, p_bff, p_mk, p_mv = [], [], [], [], [], []
    s_hg, s_gd, s_bgd, s_bff = [], [], [], []
    for l in range(DEPTH):
        lp = (lb_all[l], w_in[l], w_gd_conv[l], gd_a_log[l], gd_dt_bias[l], hg_norm_g[l],
              gd_norm_g[l], w_out[l], ln1_g[l], ln1_b[l], w_mq[l], w_mo[l], ln2_g[l], ln2_b[l],
              w_up[l], w_ffn_conv[l], b_ffn_conv[l], w_down[l], ln3_g[l], ln3_b[l])
        mkv = jnp.einsum('bmd,de->bme', mem_prompt, w_mkv[l])
        mk, mv = jnp.split(mkv, 2, axis=-1)
        mk = mk.reshape(bp, N_MEM, MEM_HEADS, MEM_HEAD_DIM)
        mv = mv.reshape(bp, N_MEM, MEM_HEADS, MEM_HEAD_DIM)
        xp, a, b, c, d = _layer(
            xp,
            jnp.zeros((bp, HG_HEADS, HG_HEAD_DIM, HG_HEAD_DIM), dt_p),
            jnp.zeros((bp, GD_HEADS, GD_HEAD_DIM, GD_HEAD_DIM), dt_p),
            jnp.zeros((bp, GD_CONV - 1, 3 * GD_WIDTH), dt_p),
            jnp.zeros((bp, FFN_CONV - 1, D_FF), dt_p),
            mk, mv, *lp)
        p_hg.append(a); p_gd.append(b); p_bgd.append(c); p_bff.append(d)
        p_mk.append(mk); p_mv.append(mv)
        xs, a, b, c, d = _layer(xs, state_hgrn[l], state_gdn[l], state_gdn_conv[l],
                                state_ffn_conv[l], cache_mem_k[l], cache_mem_v[l], *lp)
        s_hg.append(a); s_gd.append(b); s_bgd.append(c); s_bff.append(d)

    return (xp, xs,
            jnp.stack(p_hg), jnp.stack(p_gd), jnp.stack(p_bgd), jnp.stack(p_bff),
            jnp.stack(p_mk), jnp.stack(p_mv),
            jnp.stack(s_hg), jnp.stack(s_gd), jnp.stack(s_bgd), jnp.stack(s_bff))
```

```cpp
#include <hip/hip_runtime.h>
#include <cstdio>
#include <cstdint>
#define MK_N_LAUNCHES 15
namespace pg8 {
#define PG8_LAS __attribute__((address_space(3)))
typedef unsigned short bf16_t;
typedef short bf16x8 __attribute__((ext_vector_type(8)));
typedef float f32x4 __attribute__((ext_vector_type(4)));
typedef unsigned u32x4 __attribute__((ext_vector_type(4)));
constexpr int BM = 256, BK = 64, HALF = 128, HTB = HALF * BK * 2  , STAGE_BYTES = 8 * HTB, NXCD = 8, WGM = 8;

__host__ __device__ __forceinline__ int lds_byte(int r, int c) { const int st = (r >> 4) * 2 + (c >> 5), rr = r & 15, cc = c & 31, ob = rr * 64 + cc * 2; return st * 1024 + (ob ^ (((ob >> 9) & 1) << 5)); }
__host__ __device__ __forceinline__ void stage_rc(int b, int& R, int& C) { const int st = b / 1024, sb = b % 1024, swz = sb ^ (((sb >> 9) & 1) << 5); R = (st >> 1) * 16 + swz / 64; C = (st & 1) * 32 + (swz % 64) / 2; }
__host__ __device__ __forceinline__ int perm32(int rho) { const int n = rho >> 4, i = rho & 15; return 8 * (i >> 2) + 4 * n + (i & 3); }

struct Unit { int pm, pn; };
struct Gemm { const bf16_t* A; const bf16_t* Bt; int M, N, K; };

struct StaticOrder {
    int nM, nN, nwg, G, c;
    __host__ __device__ void init(int M, int N, int G_, int c_) { nM = M / BM; nN = N / BM; nwg = nM * nN; G = G_; c = c_; }
    __host__ __device__ bool next(int i, Unit& u) const {
        const long L = (long)i * G + c; if (L >= nwg) return false;
        int wgid = (int)L; { const int q = nwg / NXCD, r = nwg % NXCD, xcd = wgid % NXCD, off = wgid / NXCD; wgid = (xcd < r ? xcd * (q + 1) : r * (q + 1) + (xcd - r) * q) + off; }
        const int nig = WGM * nN, gid = wgid / nig, fm = gid * WGM, gsz = (nM - fm) < WGM ? (nM - fm) : WGM;
        u.pm = fm + ((wgid % nig) % gsz); u.pn = (wgid % nig) / gsz; return true;
    }
    __device__ __forceinline__ void a_ready(const Unit&) const {}
    __device__ __forceinline__ void done(const Unit&) const {}
};

__device__ __forceinline__ unsigned cvt_pk_bf16(float lo, float hi) { unsigned r; asm volatile("v_cvt_pk_bf16_f32 %0, %1, %2" : "=v"(r) : "v"(lo), "v"(hi)); return r; }
typedef float f32x2 __attribute__((ext_vector_type(2)));
__device__ __forceinline__ f32x2 gelu_pk(f32x2 v) {
    const f32x2 av = __builtin_elementwise_abs(v), d = av * 0.2316418882f + 1.0f;
    f32x2 t; t.x = __builtin_amdgcn_rcpf(d.x); t.y = __builtin_amdgcn_rcpf(d.y);
    f32x2 q = t * 0.5307027145f + (-0.7265760135f); q = q * t + 0.7107068705f; q = q * t + (-0.142248368f); q = q * t + 0.127414796f; q = q * t;
    const f32x2 s = (v * v) * (-0.72134752044f);
    f32x2 e; e.x = __builtin_amdgcn_exp2f(s.x); e.y = __builtin_amdgcn_exp2f(s.y);
    const f32x2 m = v * (q * e), r = v - m;
    f32x2 o; o.x = v.x < 0.f ? m.x : r.x; o.y = v.y < 0.f ? m.y : r.y; return o;
}

template <int ACT  > struct EpiBf16 {
    static constexpr bool PERM = true, AFTER_DRAIN = false; static_assert(ACT == 0 || ACT == 1, "EpiBf16: ACT is 0 (none) or 1 (gelu_pk)");
    bf16_t* O; int ldc; const float* bias; int split_cols; size_t split_stride; float scale0;
    __device__ __forceinline__ void operator()(const f32x4 (&acc)[2][2][4][2], const Unit& u, int wr, int wc, int fr, int fq) const {
        const int row0 = u.pm * BM + wr * 64 + fr; int colt = u.pn * BM; bf16_t* base = O;
        float sc = 1.f; if (split_cols) { const int t = colt / split_cols; base += (size_t)t * split_stride; colt -= t * split_cols; if (t == 0) sc = scale0; }
        const int col0 = colt + wc * 32 + 8 * fq, bcol0 = u.pn * BM + wc * 32 + 8 * fq;
        f32x4 bv[2][2];
#pragma unroll
        for (int bj = 0; bj < 2; ++bj)
#pragma unroll
            for (int n = 0; n < 2; ++n) bv[bj][n] = bias ? *(const f32x4*)(bias + bcol0 + bj * HALF + 4 * n) : (f32x4){0.f, 0.f, 0.f, 0.f};
#pragma unroll
        for (int ai = 0; ai < 2; ++ai)
#pragma unroll
            for (int m = 0; m < 4; ++m) { bf16_t* rowp = base + (size_t)(row0 + ai * HALF + m * 16) * ldc + col0;
#pragma unroll
                for (int bj = 0; bj < 2; ++bj) { f32x4 v0 = acc[ai][bj][m][0] + bv[bj][0], v1 = acc[ai][bj][m][1] + bv[bj][1];
                    if (ACT == 1) { f32x2 a = gelu_pk((f32x2){v0[0], v0[1]}), b = gelu_pk((f32x2){v0[2], v0[3]}), c = gelu_pk((f32x2){v1[0], v1[1]}), d = gelu_pk((f32x2){v1[2], v1[3]});
                        v0 = (f32x4){a.x, a.y, b.x, b.y}; v1 = (f32x4){c.x, c.y, d.x, d.y}; }
                    v0 = v0 * sc; v1 = v1 * sc; u32x4 w; w.x = cvt_pk_bf16(v0[0], v0[1]); w.y = cvt_pk_bf16(v0[2], v0[3]); w.z = cvt_pk_bf16(v1[0], v1[1]); w.w = cvt_pk_bf16(v1[2], v1[3]);
                    *(u32x4*)(rowp + bj * HALF) = w; } }
    }
};
template <class Epi, class Sched, bool ALIGN_EPI = false, bool SP2 = false>
__device__ __forceinline__ void gemm_phase(PG8_LAS unsigned char* lds, const Gemm g, const Sched& S, const Epi& E) {
    const int tid = threadIdx.x, wid = __builtin_amdgcn_readfirstlane(tid >> 6), lane = tid & 63, wr = wid >> 2, wc = wid & 3, fr = lane & 15, fq = lane >> 4;
    const int K = g.K, nt = K / BK;
    unsigned voffA[2], voffB[2];
#pragma unroll
    for (int i = 0; i < 2; ++i) { int R, C; stage_rc(tid * 16 + i * 8192, R, C); const int Rb = Epi::PERM ? ((R & ~31) + perm32(R & 31)) : R;
        voffA[i] = (unsigned)(R * K + C) * 2u; voffB[i] = (unsigned)(Rb * K + C) * 2u; }
    const size_t kstep = (size_t)(BK * 2);
    const size_t hstep = (size_t)HALF * K * 2;
    const size_t tstep = 2 * hstep;
    const unsigned ldsw = (unsigned)wid * 1024u;
    const int aoff = lds_byte(wr * 64 + fr, fq * 8), boff = lds_byte(wc * 32 + fr, fq * 8);
#define PG8_SA(b, h) (((b) * 2 + (h)) * HTB)
#define PG8_SB(b, h) ((4 + (b) * 2 + (h)) * HTB)
#define PG8_STAGE(bufoff, gbase, voff) do { _Pragma("unroll") for (int _i = 0; _i < 2; ++_i) \
        __builtin_amdgcn_global_load_lds((const unsigned*)((const char*)(gbase) + (voff)[_i]), (PG8_LAS unsigned*)(lds + (bufoff) + ldsw + _i * 8192), 16, 0, 0); } while (0)
#define PG8_LDA(dst, b, h) do { _Pragma("unroll") for (int m = 0; m < 4; ++m) _Pragma("unroll") for (int k = 0; k < 2; ++k) dst[m][k] = *(const PG8_LAS bf16x8*)(lds + PG8_SA(b, h) + aoff + m * 2048 + k * 1024); } while (0)
#define PG8_LDB(dst, b, h) do { _Pragma("unroll") for (int n = 0; n < 2; ++n) _Pragma("unroll") for (int k = 0; k < 2; ++k) dst[n][k] = *(const PG8_LAS bf16x8*)(lds + PG8_SB(b, h) + boff + n * 2048 + k * 1024); } while (0)
#define PG8_MMA(ai, bj, At, Bt) do { __builtin_amdgcn_s_setprio(1); _Pragma("unroll") for (int m = 0; m < 4; ++m) _Pragma("unroll") for (int n = 0; n < 2; ++n) _Pragma("unroll") for (int k = 0; k < 2; ++k) \
        acc[ai][bj][m][n] = __builtin_amdgcn_mfma_f32_16x16x32_bf16(Bt[n][k], At[m][k], acc[ai][bj][m][n], 0, 0, 0); __builtin_amdgcn_s_setprio(0); } while (0)
#define PG8_WAIT_V(n) asm volatile("s_waitcnt vmcnt(" #n ")" ::: "memory")
#define PG8_WAIT_L(n) asm volatile("s_waitcnt lgkmcnt(" #n ")" ::: "memory")
#define PG8_BAR __builtin_amdgcn_s_barrier()
#define PG8_SCHED __builtin_amdgcn_sched_barrier(0)
    Unit cur, nxt; int ui = 0;
    if (!S.next(0, cur)) return;
    f32x4 acc[2][2][4][2];
#pragma unroll
    for (int a = 0; a < 2; ++a)
#pragma unroll
        for (int b = 0; b < 2; ++b)
#pragma unroll
            for (int m = 0; m < 4; ++m)
#pragma unroll
                for (int n = 0; n < 2; ++n) acc[a][b][m][n] = (f32x4){0.f, 0.f, 0.f, 0.f};
    bf16x8 At[4][2], B0[2][2], B1[2][2];
    const char* cA = (const char*)g.A + (size_t)cur.pm * tstep; const char* cB = (const char*)g.Bt + (size_t)cur.pn * tstep;
    S.a_ready(cur);
    if constexpr (SP2) {
        PG8_STAGE(PG8_SB(0, 0), cB, voffB); PG8_STAGE(PG8_SB(0, 1), cB + hstep, voffB); PG8_STAGE(PG8_SA(0, 0), cA, voffA); PG8_STAGE(PG8_SA(0, 1), cA + hstep, voffA);
        if (wr == 1) PG8_BAR;
        PG8_WAIT_V(2); PG8_BAR;
        PG8_STAGE(PG8_SB(1, 0), cB + kstep, voffB); PG8_STAGE(PG8_SA(1, 0), cA + kstep, voffA); PG8_STAGE(PG8_SB(1, 1), cB + hstep + kstep, voffB);
        PG8_WAIT_V(6); PG8_BAR;
    } else {
        PG8_STAGE(PG8_SB(0, 0), cB, voffB); PG8_STAGE(PG8_SA(0, 0), cA, voffA); PG8_STAGE(PG8_SB(0, 1), cB + hstep, voffB); PG8_STAGE(PG8_SA(0, 1), cA + hstep, voffA);
        if (wr == 1) PG8_BAR;
        PG8_WAIT_V(4); PG8_BAR;
        PG8_STAGE(PG8_SB(1, 0), cB + kstep, voffB); PG8_STAGE(PG8_SA(1, 0), cA + kstep, voffA); PG8_STAGE(PG8_SB(1, 1), cB + hstep + kstep, voffB);
        PG8_WAIT_V(6); PG8_BAR;
    }
    for (;;) {
        const bool has_next = S.next(ui + 1, nxt);
        const char* nA = has_next ? (const char*)g.A + (size_t)nxt.pm * tstep : cA; const char* nB = has_next ? (const char*)g.Bt + (size_t)nxt.pn * tstep : cB;
        for (int t = 0; t < nt; t += 2) {
            const bool last = (t == nt - 2);
            const char* a1 = cA + (size_t)(t + 1) * kstep;
            const char* a2 = last ? nA : cA + (size_t)(t + 2) * kstep; const char* b2 = last ? nB : cB + (size_t)(t + 2) * kstep;
            const char* a3 = a2 + kstep; const char* b3 = b2 + kstep;
            if (last && has_next) S.a_ready(nxt);
            if constexpr (SP2) {
            PG8_LDB(B0, 0, 0); PG8_LDB(B1, 0, 1); PG8_SCHED; PG8_LDA(At, 0, 0); PG8_STAGE(PG8_SA(1, 1), a1 + hstep, voffA);
            PG8_WAIT_V(8); PG8_WAIT_L(0); PG8_BAR; PG8_MMA(0, 0, At, B0); PG8_MMA(0, 1, At, B1); PG8_BAR; PG8_SCHED;
            PG8_LDA(At, 0, 1); PG8_STAGE(PG8_SB(0, 0), b2, voffB); PG8_STAGE(PG8_SB(0, 1), b2 + hstep, voffB); PG8_STAGE(PG8_SA(0, 0), a2, voffA);
            PG8_WAIT_V(8); PG8_WAIT_L(0); PG8_BAR; PG8_MMA(1, 0, At, B0); PG8_MMA(1, 1, At, B1); PG8_BAR; PG8_SCHED;
            PG8_LDB(B0, 1, 0); PG8_LDB(B1, 1, 1); PG8_SCHED; PG8_LDA(At, 1, 0); PG8_STAGE(PG8_SA(0, 1), a2 + hstep, voffA);
            PG8_WAIT_V(8); PG8_WAIT_L(0); PG8_BAR; PG8_MMA(0, 0, At, B0); PG8_MMA(0, 1, At, B1); PG8_BAR; PG8_SCHED;
            PG8_LDA(At, 1, 1); PG8_STAGE(PG8_SB(1, 0), b3, voffB); PG8_STAGE(PG8_SB(1, 1), b3 + hstep, voffB); PG8_STAGE(PG8_SA(1, 0), a3, voffA);
            PG8_WAIT_V(8); PG8_WAIT_L(0); PG8_BAR; PG8_MMA(1, 0, At, B0); PG8_MMA(1, 1, At, B1); PG8_BAR; PG8_SCHED;
            } else {
            PG8_LDB(B0, 0, 0); PG8_SCHED; PG8_LDA(At, 0, 0); PG8_STAGE(PG8_SA(1, 1), a1 + hstep, voffA);
            PG8_WAIT_L(8); PG8_BAR; PG8_WAIT_L(0); PG8_MMA(0, 0, At, B0); PG8_BAR; PG8_SCHED;
            PG8_LDB(B1, 0, 1); PG8_STAGE(PG8_SB(0, 0), b2, voffB);
            PG8_BAR; PG8_WAIT_L(0); PG8_MMA(0, 1, At, B1); PG8_BAR;
            PG8_LDA(At, 0, 1); PG8_STAGE(PG8_SA(0, 0), a2, voffA);
            PG8_BAR; PG8_WAIT_L(0); PG8_MMA(1, 0, At, B0); PG8_BAR; PG8_SCHED;
            PG8_STAGE(PG8_SB(0, 1), b2 + hstep, voffB);
            PG8_WAIT_V(6); PG8_BAR; PG8_MMA(1, 1, At, B1); PG8_BAR;
            PG8_LDB(B0, 1, 0); PG8_SCHED; PG8_LDA(At, 1, 0); PG8_STAGE(PG8_SA(0, 1), a2 + hstep, voffA);
            PG8_WAIT_L(8); PG8_BAR; PG8_WAIT_L(0); PG8_MMA(0, 0, At, B0); PG8_BAR; PG8_SCHED;
            PG8_LDB(B1, 1, 1); PG8_STAGE(PG8_SB(1, 0), b3, voffB);
            PG8_BAR; PG8_WAIT_L(0); PG8_MMA(0, 1, At, B1); PG8_BAR;
            PG8_LDA(At, 1, 1); PG8_STAGE(PG8_SA(1, 0), a3, voffA);
            PG8_BAR; PG8_WAIT_L(0); PG8_MMA(1, 0, At, B0); PG8_BAR; PG8_SCHED;
            PG8_STAGE(PG8_SB(1, 1), b3 + hstep, voffB);
            PG8_WAIT_V(6); PG8_BAR; PG8_MMA(1, 1, At, B1); PG8_BAR;
            }
        }
        if constexpr (ALIGN_EPI) { if (wr == 0) PG8_BAR; }
        if constexpr (!Epi::AFTER_DRAIN) { E(acc, cur, wr, wc, fr, fq); S.done(cur); }
        if (!has_next) break;
#pragma unroll
        for (int a = 0; a < 2; ++a)
#pragma unroll
            for (int b = 0; b < 2; ++b)
#pragma unroll
                for (int m = 0; m < 4; ++m)
#pragma unroll
                    for (int n = 0; n < 2; ++n) acc[a][b][m][n] = (f32x4){0.f, 0.f, 0.f, 0.f};
        cur = nxt; cA = nA; cB = nB; ++ui;
        if constexpr (ALIGN_EPI) { if (wr == 1) PG8_BAR; }
    }
    PG8_WAIT_V(0);
    if constexpr (!ALIGN_EPI) { if (wr == 0) PG8_BAR; }
    PG8_BAR;
    if constexpr (Epi::AFTER_DRAIN) { E.fused(acc, cur, wr, wc, fr, fq, lds, wid, lane); S.done(cur); }
#undef PG8_SA
#undef PG8_SB
#undef PG8_STAGE
#undef PG8_LDA
#undef PG8_LDB
#undef PG8_MMA
#undef PG8_WAIT_V
#undef PG8_WAIT_L
#undef PG8_BAR
#undef PG8_SCHED
}
}

constexpr int NWAVES = 8;
constexpr int NT = NWAVES * 64;
#ifndef MK_PH_HI
#define MK_PH_HI 15
#endif
constexpr int D = 1024, MP = 16384, MS = 512, M = MP + MS;
constexpr int NMEMROWS = 2048;
constexpr int INC = 4104, PC = 4096;
constexpr int FF = 2816, UPC = 5632;
constexpr float ALPHA = 1.189207115002721f;
constexpr float LN_EPS = 1e-5f, RMS_EPS = 1e-6f;
constexpr size_t O_YP = 0, O_YS = 16777216, O_PHG = 17301504, O_PGD = 17825792, O_PGC = 18350080, O_PFC = 18386944,
                 O_PMK = 18432000, O_PMV = 20529152, O_SHG = 22626304, O_SGD = 31014912, O_SGC = 39403520, O_SFC = 39993344;
constexpr size_t MiB = 1u << 20;
constexpr size_t WS_CTL = 0, CTL_ZERO_BYTES = 1 * MiB;
constexpr size_t WS_BIG = 2 * MiB;
constexpr int BIG_XB = 0, BIG_MEMP = 16896, BIG_WIN = 18944, BIG_WMKV = 23040;
constexpr size_t WS_WOUT = 52 * MiB, WS_WMQ = 54 * MiB, WS_WMO = 56 * MiB, WS_WUP = 58 * MiB, WS_WDN = 70 * MiB;
constexpr size_t WS_GBA = 76 * MiB;
constexpr size_t WS_MKB = 77 * MiB, WS_VTB = 81 * MiB;
constexpr size_t WS_PROJ = 86 * MiB;
constexpr size_t WS_QX = 218 * MiB;
constexpr size_t WS_O0 = 250 * MiB;
constexpr size_t WS_DS = 282 * MiB;
constexpr size_t WS_MG = 410 * MiB;
constexpr size_t WS_EV = 442 * MiB;
constexpr size_t WS_ST = 444 * MiB;
constexpr size_t WS_MIX = 2 * MiB;
constexpr size_t WS_Y = 86 * MiB;
constexpr size_t WS_H1F = 152 * MiB, WS_H1B = 218 * MiB, WS_QB = 251 * MiB, WS_OB = 284 * MiB;
constexpr size_t WS_H2F = 317 * MiB, WS_H2B = 383 * MiB;
constexpr size_t WS_UP = 86 * MiB;
constexpr size_t WS_ACT = 416 * MiB;
constexpr size_t WS_NEED = 512 * MiB;
constexpr int CW_BAR = 4096;
constexpr int LDS_BYTES = 147456;
constexpr int MISC_OFF = 146432;

#define GAS __attribute__((address_space(1)))
#define LAS __attribute__((address_space(3)))
typedef unsigned short bf16;
typedef unsigned v4u __attribute__((ext_vector_type(4)));
typedef unsigned v2u __attribute__((ext_vector_type(2)));
typedef float f32x4 __attribute__((ext_vector_type(4)));
typedef short bf16x8 __attribute__((ext_vector_type(8)));
typedef float f32x16 __attribute__((ext_vector_type(16)));
typedef GAS unsigned gu32;
#define LDS_WAIT() asm volatile("s_waitcnt lgkmcnt(0)" ::: "memory")
__device__ __forceinline__ unsigned f2bf(float f) { unsigned u = __builtin_bit_cast(unsigned, f); return (u + 0x7fffu + ((u >> 16) & 1u)) >> 16; }
__device__ __forceinline__ unsigned pk2(float lo, float hi) { return f2bf(lo) | (f2bf(hi) << 16); }
__device__ __forceinline__ float bf2f(unsigned b) { return __builtin_bit_cast(float, b << 16); }
__device__ __forceinline__ float bflo(unsigned w) { return __builtin_bit_cast(float, w << 16); }
__device__ __forceinline__ float bfhi(unsigned w) { return __builtin_bit_cast(float, w & 0xffff0000u); }
__device__ __forceinline__ const float* opq(const float* p) { asm volatile("" : "+s"(p)); return p; }
__device__ __forceinline__ float sigm(float x) { return 1.0f / (1.0f + __expf(-x)); }
__device__ __forceinline__ float siluf(float x) { return x / (1.0f + __expf(-x)); }
__device__ __forceinline__ float wave_sum(float v) {
#pragma unroll
    for (int o = 1; o < 64; o <<= 1) v += __shfl_xor(v, o);
    return v;
}
__device__ __forceinline__ float wave_max(float v) {
#pragma unroll
    for (int o = 1; o < 64; o <<= 1) v = fmaxf(v, __shfl_xor(v, o));
    return v;
}
#define XB_TMO      128
#define XB_XCNT(j)  (256  + 64 * (j))
#define XB_XSUB(j)  (1280 + 64 * (j))
#define XB_XGEN(j)  (2304 + 64 * (j))
#define XB_TOP      3328
#define XB_TOPGEN   3392
#define XCD_BAR_WORDS 3456
#define XB_SPIN_CAP (1u << 18)

__device__ __forceinline__ unsigned xb_ld(unsigned* p)              { return __hip_atomic_load(p, __ATOMIC_RELAXED, __HIP_MEMORY_SCOPE_AGENT); }
__device__ __forceinline__ unsigned xb_add(unsigned* p, unsigned v) { return __hip_atomic_fetch_add(p, v, __ATOMIC_RELAXED, __HIP_MEMORY_SCOPE_AGENT); }
__device__ __forceinline__ unsigned xb_xcc_id() { return (unsigned)__builtin_amdgcn_s_getreg((3 << 11) | 20) & 0xFu; }
#define XB_SPIN(cond, bar) do { unsigned _sp = 0; while (cond) { __builtin_amdgcn_s_sleep(1); \
    if ((++_sp & 255u) == 0u) { if (xb_ld(&(bar)[XB_TMO])) break; if (_sp > XB_SPIN_CAP) { atomicAdd(&(bar)[XB_TMO], 1u); break; } } } } while (0)

struct XcdBarrier {
    unsigned* bar; unsigned x;
    volatile LAS unsigned* st;
};

__device__ __forceinline__ XcdBarrier xcd_barrier_post(unsigned* bar, volatile LAS unsigned* st) {
    XcdBarrier b; b.bar = bar; b.x = xb_xcc_id(); b.st = st;
    if (threadIdx.x == 0) (void)xb_add(&bar[XB_XCNT(b.x)], 1u);
    return b;
}
__device__ __forceinline__ void xcd_barrier_complete(unsigned* bar, unsigned x, unsigned& nloc, unsigned& nx) {
    const unsigned G = gridDim.x * gridDim.y * gridDim.z;
    unsigned sum, cnt, mine, sp = 0u;
    for (;;) {
        sum = 0u; cnt = 0u; mine = 0u;
#pragma unroll
        for (unsigned j = 0; j < 16; ++j) { const unsigned c = xb_ld(&bar[XB_XCNT(j)]); sum += c; cnt += (c > 0u) ? 1u : 0u; mine = (j == x) ? c : mine; }
        if (sum == G) break;
        __builtin_amdgcn_s_sleep(1);
        if ((++sp & 255u) == 0u) { if (xb_ld(&bar[XB_TMO])) break; if (sp > XB_SPIN_CAP) { atomicAdd(&bar[XB_TMO], 1u); break; } }
    }
    nloc = mine > 0u ? mine : 1u; nx = cnt > 0u ? cnt : 1u;
}

__device__ __forceinline__ void xcd_barrier(const XcdBarrier& b) {
    asm volatile("s_waitcnt vmcnt(0)" ::: "memory");
    __syncthreads();
    if (threadIdx.x == 0) {
        unsigned* bar = b.bar;
        __builtin_amdgcn_s_waitcnt(0);
        unsigned nloc = b.st[0], nx = b.st[1];
        if (nloc == 0u) { xcd_barrier_complete(bar, b.x, nloc, nx); b.st[0] = nloc; b.st[1] = nx; }
        const unsigned old = xb_add(&bar[XB_XSUB(b.x)], 1u);
        const unsigned gen = old / nloc;
        if (old + 1u == (gen + 1u) * nloc) {
            __builtin_amdgcn_fence(__ATOMIC_RELEASE, "agent");
            asm volatile("s_waitcnt vmcnt(0)" ::: "memory");
            const unsigned og = xb_add(&bar[XB_TOP], 1u);
            const unsigned tg = og / nx;
            if (og + 1u == (tg + 1u) * nx) xb_add(&bar[XB_TOPGEN], 1u);
            else XB_SPIN(xb_ld(&bar[XB_TOPGEN]) == tg, bar);
            __builtin_amdgcn_fence(__ATOMIC_ACQUIRE, "agent");
            xb_add(&bar[XB_XGEN(b.x)], 1u);
            asm volatile("s_waitcnt vmcnt(0)" ::: "memory");
        } else {
            XB_SPIN(xb_ld(&bar[XB_XGEN(b.x)]) == gen, bar);
            __builtin_amdgcn_fence(__ATOMIC_ACQUIRE, "agent");
            asm volatile("s_waitcnt vmcnt(0)" ::: "memory");
        }
    }
    __syncthreads();
}

template <int MT, int NTL>
__device__ __forceinline__ void mma_lds(f32x4 (&acc)[MT][NTL], const LAS bf16* A, int lda, const LAS bf16* B, int ldb, int K, int lane) {
    const int fr = lane & 15, fq = lane >> 4;
    for (int k0 = 0; k0 < K; k0 += 32) {
        bf16x8 a[MT], b[NTL];
#pragma unroll
        for (int i = 0; i < MT; ++i) a[i] = *(const LAS bf16x8*)(A + (16 * i + fr) * lda + k0 + 8 * fq);
#pragma unroll
        for (int j = 0; j < NTL; ++j) b[j] = *(const LAS bf16x8*)(B + (16 * j + fr) * ldb + k0 + 8 * fq);
#pragma unroll
        for (int i = 0; i < MT; ++i)
#pragma unroll
            for (int j = 0; j < NTL; ++j) acc[i][j] = __builtin_amdgcn_mfma_f32_16x16x32_bf16(b[j], a[i], acc[i][j], 0, 0, 0);
    }
}
template <int MT, int NTL> __device__ __forceinline__ void zero_acc(f32x4 (&acc)[MT][NTL]) {
#pragma unroll
    for (int i = 0; i < MT; ++i)
#pragma unroll
        for (int j = 0; j < NTL; ++j) acc[i][j] = (f32x4){0.f, 0.f, 0.f, 0.f};
}

struct Frame {
    LAS unsigned char* lds;
    volatile LAS unsigned* MISC;
    gu32* ctl;
    int tid, lane, wave, G;
    const float* in[30];
    float* out;
    unsigned char* ws;
};

__device__ __forceinline__ void p0_transpose_item(const float* W, int ldw, int K, int nblk, bf16* WT, LAS float* scr, int item, int lane) {
    const int kb = item / nblk, nb = item % nblk, k0 = 64 * kb, n0 = 32 * nb;
#pragma unroll 8
    for (int i = 0; i < 32; ++i) { const int kk = 2 * i + (lane >> 5); scr[kk * 33 + (lane & 31)] = W[(size_t)(k0 + kk) * ldw + n0 + (lane & 31)]; }
    LDS_WAIT(); asm volatile("" ::: "memory");
    const int c = lane & 7;
#pragma unroll
    for (int j = 0; j < 4; ++j) { const int n = (lane >> 3) + 8 * j; const LAS float* s = scr + (8 * c) * 33 + n;
        v4u o; o.x = pk2(s[0 * 33], s[1 * 33]); o.y = pk2(s[2 * 33], s[3 * 33]); o.z = pk2(s[4 * 33], s[5 * 33]); o.w = pk2(s[6 * 33], s[7 * 33]);
        *(GAS v4u*)(WT + (size_t)(n0 + n) * K + k0 + 8 * c) = o; }
    LDS_WAIT(); asm volatile("" ::: "memory");
}
__device__ __forceinline__ void p0_prologue(Frame& F) {
    unsigned char* ws = F.ws;
    bf16* BIG = (bf16*)(ws + WS_BIG);
    LAS float* scr = (LAS float*)(F.lds + F.wave * 8704);
    LAS float* wtab = (LAS float*)(F.lds + 73728);
    const float* w_in = F.in[10];
    for (int i = F.tid; i < 8192; i += NT) { const int k = i >> 3, c = i & 7; wtab[c * 1024 + k] = w_in[(size_t)k * INC + PC + c]; }
    __syncthreads();
    const int gw = blockIdx.x * NWAVES + F.wave, NGW = F.G * NWAVES;
    constexpr int I_IN = 16 * 128, I_MKV = 16 * 64, I_SQ = 16 * 32, I_UP = 16 * 176, I_DN = 44 * 32;
    constexpr int NITEMS = I_IN + I_MKV + 3 * I_SQ + I_UP + I_DN;
    for (int it = gw; it < NITEMS; it += NGW) {
        int r = it;
        if (r < I_IN) { p0_transpose_item(F.in[10], INC, D, 128, BIG + (size_t)BIG_WIN * D, scr, r, F.lane); continue; } r -= I_IN;
        if (r < I_MKV) { p0_transpose_item(F.in[20], 2048, D, 64, BIG + (size_t)BIG_WMKV * D, scr, r, F.lane); continue; } r -= I_MKV;
        if (r < I_SQ) { p0_transpose_item(F.in[16], D, D, 32, (bf16*)(ws + WS_WOUT), scr, r, F.lane); continue; } r -= I_SQ;
        if (r < I_SQ) { p0_transpose_item(F.in[19], D, D, 32, (bf16*)(ws + WS_WMQ), scr, r, F.lane); continue; } r -= I_SQ;
        if (r < I_SQ) { p0_transpose_item(F.in[21], D, D, 32, (bf16*)(ws + WS_WMO), scr, r, F.lane); continue; } r -= I_SQ;
        if (r < I_UP) { p0_transpose_item(F.in[24], UPC, D, 176, (bf16*)(ws + WS_WUP), scr, r, F.lane); continue; } r -= I_UP;
        p0_transpose_item(F.in[27], D, FF, 32, (bf16*)(ws + WS_WDN), scr, r, F.lane);
    }
    float* GBA = (float*)(ws + WS_GBA);
    for (int row = gw; row < M + NMEMROWS; row += NGW) {
        const float* src = row < MP ? F.in[0] + (size_t)row * D : (row < M ? F.in[1] + (size_t)(row - MP) * D : F.in[8] + (size_t)(row - M) * D);
        const GAS f32x4* xr = (const GAS f32x4*)src + F.lane;
        f32x4 v[4];
#pragma unroll
        for (int j = 0; j < 4; ++j) v[j] = xr[64 * j];
        GAS v2u* o8 = (GAS v2u*)(BIG + (size_t)row * D) + F.lane;
#pragma unroll
        for (int j = 0; j < 4; ++j) { v2u w; w.x = pk2(v[j].x, v[j].y); w.y = pk2(v[j].z, v[j].w); o8[64 * j] = w; }
        if (row < M) {
            float dsum[8];
#pragma unroll
            for (int c = 0; c < 8; ++c) { float s = 0.f;
#pragma unroll
                for (int j = 0; j < 4; ++j) { const f32x4 w = *(const LAS f32x4*)(wtab + c * 1024 + 256 * j + 4 * F.lane); s += v[j].x * w.x + v[j].y * w.y + v[j].z * w.z + v[j].w * w.w; }
                dsum[c] = wave_sum(s); }
            if (F.lane == 0) { *(GAS f32x4*)(GBA + (size_t)row * 8) = (f32x4){dsum[0], dsum[1], dsum[2], dsum[3]}; *(GAS f32x4*)(GBA + (size_t)row * 8 + 4) = (f32x4){dsum[4], dsum[5], dsum[6], dsum[7]}; }
        }
    }
}

struct OrderP1 {
    pg8::StaticOrder so; int G, c;
    __device__ void init(int G_, int c_) { G = G_; c = c_; so.init(M, PC, G_, c_); }
    __device__ bool next(int i, pg8::Unit& u) const {
        const long L = (long)i * G + c;
        if (L < 1056) { so.next(i, u); u.pn += 74; return true; }
        if (L < 1120) { const int j = (int)L - 1056; u.pm = 66 + (j >> 3); u.pn = 90 + (j & 7); return true; }
        if (L < 1152) { const int j = (int)L - 1120; u.pm = 94 + (j >> 3); u.pn = 66 + (j & 7); return true; }
        return false;
    }
    __device__ __forceinline__ void a_ready(const pg8::Unit&) const {}
    __device__ __forceinline__ void done(const pg8::Unit&) const {}
};
struct EpiP1 {
    static constexpr bool PERM = true, AFTER_DRAIN = false;
    bf16* proj; float* out_mk; float* out_mv; bf16* mkb; bf16* vtb;
    __device__ __forceinline__ void operator()(const pg8::f32x4 (&acc)[2][2][4][2], const pg8::Unit& u, int wr, int wc, int fr, int fq) const {
        const int rl = wr * 64 + fr, cl = wc * 32 + 8 * fq;
        int kind, rbase, cbase;
        if (u.pn >= 74 && u.pn < 90) { kind = 0; rbase = u.pm * 256; cbase = (u.pn - 74) * 256; }
        else if (u.pn >= 90) { kind = 1; rbase = (u.pm - 66) * 256; cbase = (u.pn - 90) * 256; }
        else { kind = 2; rbase = (u.pm - 94) * 256; cbase = (u.pn - 66) * 256; }
#pragma unroll
        for (int ai = 0; ai < 2; ++ai)
#pragma unroll
            for (int m = 0; m < 4; ++m) { const int row = rbase + rl + ai * 128 + m * 16;
#pragma unroll
                for (int bj = 0; bj < 2; ++bj) { const int col = cbase + cl + bj * 128; const pg8::f32x4 v0 = acc[ai][bj][m][0], v1 = acc[ai][bj][m][1];
                    pg8::u32x4 w; w.x = pg8::cvt_pk_bf16(v0[0], v0[1]); w.y = pg8::cvt_pk_bf16(v0[2], v0[3]); w.z = pg8::cvt_pk_bf16(v1[0], v1[1]); w.w = pg8::cvt_pk_bf16(v1[2], v1[3]);
                    if (kind == 0) { *(pg8::u32x4*)(proj + (size_t)row * PC + col) = w; }
                    else if (kind == 1) {
                        if (col < 1024) { float* o = out_mk + (size_t)row * 1024 + col; *(pg8::f32x4*)o = v0; *(pg8::f32x4*)(o + 4) = v1; *(pg8::u32x4*)(mkb + (size_t)row * 1024 + col) = w; }
                        else { float* o = out_mv + (size_t)row * 1024 + (col - 1024); *(pg8::f32x4*)o = v0; *(pg8::f32x4*)(o + 4) = v1; }
                    } else { *(pg8::u32x4*)(vtb + (size_t)row * 2048 + col) = w; }
                } }
    }
};
struct EpiRes {
    static constexpr bool PERM = false, AFTER_DRAIN = false;
    const float* res0; const float* res1; int split; float* Y;
    __device__ __forceinline__ void operator()(const pg8::f32x4 (&acc)[2][2][4][2], const pg8::Unit& u, int wr, int wc, int fr, int fq) const {
        const int row0 = u.pm * 256 + wr * 64 + fr, col0 = u.pn * 256 + wc * 32 + 4 * fq;
#pragma unroll
        for (int ai = 0; ai < 2; ++ai)
#pragma unroll
            for (int m = 0; m < 4; ++m) { const int row = row0 + ai * 128 + m * 16;
                const float* rp = (row < split ? res0 + (size_t)row * D : res1 + (size_t)(row - split) * D) + col0; float* yp = Y + (size_t)row * D + col0;
#pragma unroll
                for (int bj = 0; bj < 2; ++bj)
#pragma unroll
                    for (int n = 0; n < 2; ++n) { const pg8::f32x4 r = *(const pg8::f32x4*)(rp + bj * 128 + n * 16); *(pg8::f32x4*)(yp + bj * 128 + n * 16) = r * ALPHA + acc[ai][bj][m][n]; } }
    }
};

__device__ __forceinline__ void p2_hgrn_item(Frame& F, int j) {
    unsigned char* ws = F.ws;
    const int b = j >> 7, h = (j >> 5) & 3, c = j & 31, item = j;
    const int R0 = b * 2048 + c * 64;
    LAS bf16* QT = (LAS bf16*)(F.lds);
    LAS bf16* KT = (LAS bf16*)(F.lds + 17408);
    LAS bf16* KH = (LAS bf16*)(F.lds + 34816);
    LAS bf16* VT = (LAS bf16*)(F.lds + 53248);
    LAS bf16* SC = (LAS bf16*)(F.lds + 71680);
    LAS float* PART = (LAS float*)(F.lds + 80896);
    const bf16* PROJ = (const bf16*)(ws + WS_PROJ);
    bf16* QXg = (bf16*)(ws + WS_QX) + (size_t)item * 8192;
    bf16* O0g = (bf16*)(ws + WS_O0) + (size_t)item * 8192;
    float* DSg = (float*)(ws + WS_DS) + (size_t)item * 16384;
    float* EVg = (float*)(ws + WS_EV) + (size_t)item * 128;
    int tid = F.tid; asm volatile("" : "+v"(tid));
    const int lane = tid & 63, w = F.wave;
    {
        const int d = tid & 127, tq = tid >> 7, ch = h * 128 + d;
        const float l0 = F.in[9][ch], l1 = F.in[9][512 + ch];
        const float lb = 1.0f / (1.0f + __expf(l1 - l0));
        const bf16* pr = PROJ + (size_t)(R0 + 16 * tq) * PC + ch;
        float q[16], k[16], gc[16]; unsigned vraw[16];
        float run = 0.f;
#pragma unroll
        for (int i = 0; i < 16; ++i) {
            const float hq = bf2f(pr[(size_t)i * PC]), hf = bf2f(pr[(size_t)i * PC + 512]); vraw[i] = pr[(size_t)i * PC + 1024];
            q[i] = siluf(hq);
            const float kk = (1.0f - lb) / (1.0f + __expf(hf));
            const float f = 1.0f - kk;
            k[i] = kk; run += __logf(f); gc[i] = run;
        }
        PART[tq * 128 + d] = run;
        __syncthreads();
        const float p0 = PART[d], p1 = PART[128 + d], p2 = PART[256 + d], p3 = PART[384 + d];
        const float off = (tq > 0 ? p0 : 0.f) + (tq > 1 ? p1 : 0.f) + (tq > 2 ? p2 : 0.f);
        const float gl = (p0 + p1) + (p2 + p3), r = p0 + p1;
        unsigned khp[8];
#pragma unroll
        for (int i = 0; i < 16; ++i) {
            const float g = gc[i] + off; const int s = 16 * tq + i;
            const float qt = q[i] * __expf(g - r), kt = k[i] * __expf(r - g), qh = q[i] * __expf(g), kh = k[i] * __expf(gl - g);
            QT[s * 136 + d] = (bf16)f2bf(qt); KT[s * 136 + d] = (bf16)f2bf(kt);
            QXg[s * 128 + d] = (bf16)f2bf(qh);
            if (i & 1) khp[i >> 1] |= f2bf(kh) << 16; else khp[i >> 1] = f2bf(kh);
        }
        *(LAS v4u*)(KH + d * 72 + 16 * tq) = (v4u){khp[0], khp[1], khp[2], khp[3]};
        *(LAS v4u*)(KH + d * 72 + 16 * tq + 8) = (v4u){khp[4], khp[5], khp[6], khp[7]};
        *(LAS v4u*)(VT + d * 72 + 16 * tq) = (v4u){vraw[0] | (vraw[1] << 16), vraw[2] | (vraw[3] << 16), vraw[4] | (vraw[5] << 16), vraw[6] | (vraw[7] << 16)};
        *(LAS v4u*)(VT + d * 72 + 16 * tq + 8) = (v4u){vraw[8] | (vraw[9] << 16), vraw[10] | (vraw[11] << 16), vraw[12] | (vraw[13] << 16), vraw[14] | (vraw[15] << 16)};
        if (tq == 0) EVg[d] = __expf(gl);
    }
    __syncthreads();
    const int fr = lane & 15, fq = lane >> 4;
    {
        const int i = w & 3, jj0 = 2 * (w >> 2);
        f32x4 acc[1][2]; zero_acc(acc);
        if (jj0 <= i) mma_lds<1, 2>(acc, QT + 16 * i * 136, 136, KT + 16 * jj0 * 136, 136, 128, lane);
        const int t = 16 * i + fr;
#pragma unroll
        for (int jj = 0; jj < 2; ++jj) { const int s0 = 16 * (jj0 + jj) + 4 * fq; const f32x4 a = acc[0][jj];
            v2u o; o.x = pk2(s0 <= t ? a[0] : 0.f, s0 + 1 <= t ? a[1] : 0.f); o.y = pk2(s0 + 2 <= t ? a[2] : 0.f, s0 + 3 <= t ? a[3] : 0.f);
            *(LAS v2u*)(SC + t * 72 + s0) = o; }
    }
    __syncthreads();
    {
        const int i = w & 3, n0 = 64 * (w >> 2);
        f32x4 acc[1][4]; zero_acc(acc);
        mma_lds<1, 4>(acc, SC + 16 * i * 72, 72, VT + n0 * 72, 72, 64, lane);
        const int t = 16 * i + fr;
#pragma unroll
        for (int jn = 0; jn < 4; ++jn) { const int v0 = n0 + 16 * jn + 4 * fq; const f32x4 a = acc[0][jn];
            v2u o; o.x = pk2(a[0], a[1]); o.y = pk2(a[2], a[3]); *(GAS v2u*)(O0g + t * 128 + v0) = o; }
    }
    {
        f32x4 acc[1][8]; zero_acc(acc);
        mma_lds<1, 8>(acc, VT + 16 * w * 72, 72, KH, 72, 64, lane);
        const int v = 16 * w + fr;
#pragma unroll
        for (int jn = 0; jn < 8; ++jn) *(GAS f32x4*)(DSg + v * 128 + 16 * jn + 4 * fq) = acc[0][jn];
    }
    __syncthreads();
}

__device__ __forceinline__ void p2_gdn_item(Frame& F, int j) {
    unsigned char* ws = F.ws;
    const int b = j >> 7, h = (j >> 5) & 3, c = j & 31, item = 1024 + j;
    const int R0 = b * 2048 + c * 64;
    LAS bf16* RAW = (LAS bf16*)(F.lds);
    LAS bf16* XT = (LAS bf16*)(F.lds);
    LAS bf16* AQ = (LAS bf16*)(F.lds + 36864);
    LAS bf16* QS = (LAS bf16*)(F.lds + 52736);
    LAS bf16* KS = (LAS bf16*)(F.lds + 70144);
    LAS bf16* VS = (LAS bf16*)(F.lds + 87552);
    LAS float* AM = (LAS float*)(F.lds + 104960);
    LAS bf16* KH = (LAS bf16*)(F.lds + 122368);
    LAS float* SM = (LAS float*)(F.lds + 140800);
    LAS float* LA = SM, *GC = SM + 64, *BETA = SM + 128, *BG = SM + 192, *GAM = SM + 256;
    const bf16* PROJ = (const bf16*)(ws + WS_PROJ);
    const float* GBA = (const float*)(ws + WS_GBA);
    bf16* QXg = (bf16*)(ws + WS_QX) + (size_t)item * 8192;
    bf16* O0g = (bf16*)(ws + WS_O0) + (size_t)item * 8192;
    float* DSg = (float*)(ws + WS_DS) + (size_t)item * 16384;
    bf16* MGg = (bf16*)(ws + WS_MG) + (size_t)j * 16384;
    float* EVg = (float*)(ws + WS_EV) + (size_t)item * 128;
    int tid = F.tid; asm volatile("" : "+v"(tid));
    const int lane = tid & 63, w = F.wave;
    for (int q = tid; q < 67 * 48; q += NT) {
        const int rr = q / 48, rem = q % 48, seg = rem >> 4, ck = rem & 15;
        v4u val = (v4u){0u, 0u, 0u, 0u};
        if (c > 0 || rr >= 3) val = *(const GAS v4u*)(PROJ + (size_t)(R0 - 3 + rr) * PC + 2048 + seg * 512 + h * 128 + ck * 8);
        *(LAS v4u*)(RAW + rr * 392 + seg * 128 + ck * 8) = val;
    }
    __syncthreads();
    {
        const int t = tid >> 3, p = tid & 7;
        const float* wconv = F.in[11];
#pragma unroll
        for (int seg = 0; seg < 3; ++seg) {
            float y[16];
#pragma unroll
            for (int dd = 0; dd < 16; ++dd) y[dd] = 0.f;
#pragma unroll
            for (int tap = 0; tap < 4; ++tap) {
                const LAS bf16* rp = RAW + (t + tap) * 392 + seg * 128 + 16 * p;
                const v4u r0 = *(const LAS v4u*)rp, r1 = *(const LAS v4u*)(rp + 8);
                const float* wp = wconv + tap * 1536 + seg * 512 + h * 128 + 16 * p;
                const f32x4 w0 = *(const f32x4*)wp, w1 = *(const f32x4*)(wp + 4), w2 = *(const f32x4*)(wp + 8), w3 = *(const f32x4*)(wp + 12);
                y[0] += bflo(r0.x) * w0.x; y[1] += bfhi(r0.x) * w0.y; y[2] += bflo(r0.y) * w0.z; y[3] += bfhi(r0.y) * w0.w;
                y[4] += bflo(r0.z) * w1.x; y[5] += bfhi(r0.z) * w1.y; y[6] += bflo(r0.w) * w1.z; y[7] += bfhi(r0.w) * w1.w;
                y[8] += bflo(r1.x) * w2.x; y[9] += bfhi(r1.x) * w2.y; y[10] += bflo(r1.y) * w2.z; y[11] += bfhi(r1.y) * w2.w;
                y[12] += bflo(r1.z) * w3.x; y[13] += bfhi(r1.z) * w3.y; y[14] += bflo(r1.w) * w3.z; y[15] += bfhi(r1.w) * w3.w;
            }
            float ss = 0.f;
#pragma unroll
            for (int dd = 0; dd < 16; ++dd) { y[dd] = siluf(y[dd]); ss += y[dd] * y[dd]; }
            float sc = 1.0f;
            if (seg < 2) { ss += __shfl_xor(ss, 1); ss += __shfl_xor(ss, 2); ss += __shfl_xor(ss, 4); sc = rsqrtf(ss + RMS_EPS) * (seg == 0 ? 0.08838834764831845f : 1.0f); }
            LAS bf16* dst = (seg == 0 ? QS : (seg == 1 ? KS : VS)) + t * 136 + 16 * p;
            *(LAS v4u*)dst = (v4u){pk2(y[0] * sc, y[1] * sc), pk2(y[2] * sc, y[3] * sc), pk2(y[4] * sc, y[5] * sc), pk2(y[6] * sc, y[7] * sc)};
            *(LAS v4u*)(dst + 8) = (v4u){pk2(y[8] * sc, y[9] * sc), pk2(y[10] * sc, y[11] * sc), pk2(y[12] * sc, y[13] * sc), pk2(y[14] * sc, y[15] * sc)};
        }
        if (p == 0) {
            const float gb = GBA[(size_t)(R0 + t) * 8 + h], ga = GBA[(size_t)(R0 + t) * 8 + 4 + h];
            const float x = ga + F.in[13][h];
            const float sp = x > 20.f ? x : log1pf(__expf(x));
            LA[t] = -__expf(F.in[12][h]) * sp; BETA[t] = sigm(gb);
        }
    }
    __syncthreads();
    if (tid < 64) {
        float x = LA[tid];
#pragma unroll
        for (int o = 1; o < 64; o <<= 1) { const float y = __shfl_up(x, o); if (tid >= o) x += y; }
        GC[tid] = x; const float gm = __expf(x); GAM[tid] = gm; BG[tid] = BETA[tid] * gm;
    }
    __syncthreads();
    const float gl = GC[63];
    const int fr = lane & 15, fq = lane >> 4;
    {
        const int i = w & 3, jj0 = 2 * (w >> 2);
        f32x4 akk[1][2], aqk[1][2]; zero_acc(akk); zero_acc(aqk);
        if (jj0 <= i) { mma_lds<1, 2>(akk, KS + 16 * i * 136, 136, KS + 16 * jj0 * 136, 136, 128, lane); mma_lds<1, 2>(aqk, QS + 16 * i * 136, 136, KS + 16 * jj0 * 136, 136, 128, lane); }
        const int t = 16 * i + fr; const float gt = GC[t], bt = BETA[t];
#pragma unroll
        for (int jj = 0; jj < 2; ++jj) { const int s0 = 16 * (jj0 + jj) + 4 * fq; f32x4 am, aq;
#pragma unroll
            for (int e = 0; e < 4; ++e) { const int s = s0 + e; const float dec = __expf(fminf(gt - GC[s], 0.f)); am[e] = s < t ? bt * akk[0][jj][e] * dec : 0.f; aq[e] = s <= t ? aqk[0][jj][e] * dec : 0.f; }
            *(LAS f32x4*)(AM + t * 68 + s0) = am;
            v2u o; o.x = pk2(aq[0], aq[1]); o.y = pk2(aq[2], aq[3]); *(LAS v2u*)(AQ + t * 72 + s0) = o; }
        const int d = tid & 127, tq = tid >> 7; unsigned khp[8];
#pragma unroll
        for (int ii = 0; ii < 16; ++ii) { const int s = 16 * tq + ii; const float kh = bf2f(KS[s * 136 + d]) * __expf(gl - GC[s]);
            if (ii & 1) khp[ii >> 1] |= f2bf(kh) << 16; else khp[ii >> 1] = f2bf(kh); }
        *(LAS v4u*)(KH + d * 72 + 16 * tq) = (v4u){khp[0], khp[1], khp[2], khp[3]};
        *(LAS v4u*)(KH + d * 72 + 16 * tq + 8) = (v4u){khp[4], khp[5], khp[6], khp[7]};
    }
    __syncthreads();
#ifndef NO_SOLVE
    if (tid < 256) {
        const int cc = tid; const LAS bf16* src = cc < 128 ? KS + cc : VS + (cc - 128); const LAS float* sc = cc < 128 ? BG : BETA;
        int zoff = 0; asm volatile("" : "+v"(zoff));
        const LAS float* AMv = AM + zoff;
        float x[64];
        f32x4 cur[4], nxt[4];
#pragma unroll
        for (int i = 0; i < 4; ++i) cur[i] = *(const LAS f32x4*)(AMv + i * 68);
#pragma unroll
        for (int tb = 0; tb < 16; ++tb) {
            float a[4];
#pragma unroll
            for (int i = 0; i < 4; ++i) a[i] = sc[4 * tb + i] * bf2f(src[(4 * tb + i) * 136]);
#pragma unroll
            for (int s4 = 0; s4 <= tb; ++s4) {
                if (s4 < tb) {
#pragma unroll
                    for (int i = 0; i < 4; ++i) nxt[i] = *(const LAS f32x4*)(AMv + (4 * tb + i) * 68 + 4 * (s4 + 1));
                } else if (tb < 15) {
#pragma unroll
                    for (int i = 0; i < 4; ++i) nxt[i] = *(const LAS f32x4*)(AMv + (4 * (tb + 1) + i) * 68);
                }
                if (s4 < tb) {
#pragma unroll
                    for (int i = 0; i < 4; ++i) { a[i] -= cur[i][0] * x[4 * s4]; a[i] -= cur[i][1] * x[4 * s4 + 1]; a[i] -= cur[i][2] * x[4 * s4 + 2]; a[i] -= cur[i][3] * x[4 * s4 + 3]; }
                } else {
                    x[4 * tb] = a[0];
                    a[1] -= cur[1][0] * x[4 * tb]; x[4 * tb + 1] = a[1];
                    a[2] -= cur[2][0] * x[4 * tb]; a[2] -= cur[2][1] * x[4 * tb + 1]; x[4 * tb + 2] = a[2];
                    a[3] -= cur[3][0] * x[4 * tb]; a[3] -= cur[3][1] * x[4 * tb + 1]; a[3] -= cur[3][2] * x[4 * tb + 2]; x[4 * tb + 3] = a[3];
                }
                asm volatile("" : "+v"(a[0]), "+v"(a[1]), "+v"(a[2]), "+v"(a[3]) :: "memory");
#pragma unroll
                for (int i = 0; i < 4; ++i) cur[i] = nxt[i];
            }
        }
#pragma unroll
        for (int g = 0; g < 8; ++g) *(LAS v4u*)(XT + cc * 72 + 8 * g) = (v4u){pk2(x[8 * g], x[8 * g + 1]), pk2(x[8 * g + 2], x[8 * g + 3]), pk2(x[8 * g + 4], x[8 * g + 5]), pk2(x[8 * g + 6], x[8 * g + 7])};
    }
    __syncthreads();
#endif
    {
        const int i = w & 3, half = w >> 2;
        f32x4 acc[1][8]; zero_acc(acc);
        mma_lds<1, 8>(acc, AQ + 16 * i * 72, 72, XT + 128 * half * 72, 72, 64, lane);
        const int t = 16 * i + fr;
        if (half == 0) { const float gm = GAM[t];
#pragma unroll
            for (int jn = 0; jn < 8; ++jn) { const int c0 = 16 * jn + 4 * fq; const v2u qq = *(const LAS v2u*)(QS + t * 136 + c0); const f32x4 a = acc[0][jn];
                v2u o; o.x = pk2(gm * bflo(qq.x) - a[0], gm * bfhi(qq.x) - a[1]); o.y = pk2(gm * bflo(qq.y) - a[2], gm * bfhi(qq.y) - a[3]); *(GAS v2u*)(QXg + t * 128 + c0) = o; }
        } else {
#pragma unroll
            for (int jn = 0; jn < 8; ++jn) { const int c0 = 16 * jn + 4 * fq; const f32x4 a = acc[0][jn]; v2u o; o.x = pk2(a[0], a[1]); o.y = pk2(a[2], a[3]); *(GAS v2u*)(O0g + t * 128 + c0) = o; }
        }
    }
    {
        const int d = 16 * w + fr;
        { f32x4 acc[1][8]; zero_acc(acc);
          mma_lds<1, 8>(acc, KH + 16 * w * 72, 72, XT, 72, 64, lane);
#pragma unroll
          for (int jn = 0; jn < 8; ++jn) { const f32x4 a = acc[0][jn]; v2u o; o.x = pk2(-a[0], -a[1]); o.y = pk2(-a[2], -a[3]); *(GAS v2u*)(MGg + d * 128 + 16 * jn + 4 * fq) = o; } }
        { f32x4 acc[1][8]; zero_acc(acc);
          mma_lds<1, 8>(acc, KH + 16 * w * 72, 72, XT + 128 * 72, 72, 64, lane);
#pragma unroll
          for (int jn = 0; jn < 8; ++jn) *(GAS f32x4*)(DSg + d * 128 + 16 * jn + 4 * fq) = acc[0][jn]; }
    }
    if (tid == 0) EVg[0] = __expf(gl);
    __syncthreads();
}

__device__ __forceinline__ void p2_phase(Frame& F) {
    for (int it = blockIdx.x; it < 2048; it += F.G) {
#ifndef P2_NO_HG
        if (it < 1024) p2_hgrn_item(F, it);
#endif
#ifndef P2_NO_GD
        if (it >= 1024) p2_gdn_item(F, it - 1024);
#endif
    }
    const bf16* PROJ = (const bf16*)(F.ws + WS_PROJ);
    const int gt = blockIdx.x * NT + F.tid, NGT = F.G * NT;
    for (int i = gt; i < 8 * 3 * 1536; i += NGT) { const int ch = i % 1536, jr = (i / 1536) % 3, b = i / (3 * 1536); F.out[O_PGC + i] = bf2f(PROJ[(size_t)(b * 2048 + 2045 + jr) * PC + 2048 + ch]); }
    for (int i = gt; i < 128 * 3 * 1536; i += NGT) { const int ch = i % 1536, jr = (i / 1536) % 3, b = i / (3 * 1536); F.out[O_SGC + i] = bf2f(PROJ[(size_t)(MP + b * 4 + 1 + jr) * PC + 2048 + ch]); }
}

__device__ __forceinline__ void p3_gdn_scan(Frame& F, int wi) {
    unsigned char* ws = F.ws;
    const int bh = wi >> 1, vh = wi & 1;
    int tid = F.tid; asm volatile("" : "+v"(tid));
    const int lane = tid & 63, w = F.wave;
    const int i = w & 3, jn = w >> 2, r = lane & 31, hh = lane >> 5;
    LAS bf16* SB0 = (LAS bf16*)(F.lds);
    const bf16* MG = (const bf16*)(ws + WS_MG);
    const float* DS = (const float*)(ws + WS_DS);
    const float* EV = (const float*)(ws + WS_EV);
    bf16* ST = (bf16*)(ws + WS_ST);
    f32x16 acc;
#pragma unroll
    for (int q = 0; q < 16; ++q) acc[q] = 0.f;
    int buf = 0;
    for (int c = 0; c < 32; ++c) {
        const int j = bh * 32 + c; const size_t item = 1024 + j;
        LAS bf16* SB = SB0 + buf * (64 * 136);
        bf16x8 a[8];
#pragma unroll
        for (int s = 0; s < 8; ++s) a[s] = *(const GAS bf16x8*)(MG + (size_t)j * 16384 + (32 * i + r) * 128 + 16 * s + 8 * hh);
        float nn[16];
#pragma unroll
        for (int q = 0; q < 16; ++q) nn[q] = DS[item * 16384 + (size_t)(32 * i + (q & 3) + 8 * (q >> 2) + 4 * hh) * 128 + 64 * vh + 32 * jn + r];
        const float e = EV[item * 128];
#pragma unroll
        for (int g = 0; g < 4; ++g) { v2u o; o.x = pk2(acc[4 * g], acc[4 * g + 1]); o.y = pk2(acc[4 * g + 2], acc[4 * g + 3]); *(LAS v2u*)(SB + (32 * jn + r) * 136 + 32 * i + 8 * g + 4 * hh) = o; }
        __syncthreads();
#pragma unroll
        for (int u = 0; u < 2; ++u) { const int q = tid + NT * u, vloc = q >> 4, dk0 = (q & 15) * 8;
            *(GAS v4u*)(ST + item * 16384 + (size_t)(64 * vh + vloc) * 128 + dk0) = *(const LAS v4u*)(SB + vloc * 136 + dk0); }
#pragma unroll
        for (int q = 0; q < 16; ++q) acc[q] = e * acc[q] + nn[q];
#pragma unroll
        for (int s = 0; s < 8; ++s) { const bf16x8 bb = *(const LAS bf16x8*)(SB + (32 * jn + r) * 136 + 16 * s + 8 * hh); acc = __builtin_amdgcn_mfma_f32_32x32x16_bf16(a[s], bb, acc, 0, 0, 0); }
        buf ^= 1;
    }
    float* outp = F.out + O_PGD + (size_t)bh * 16384;
#pragma unroll
    for (int q = 0; q < 16; ++q) outp[(size_t)(32 * i + (q & 3) + 8 * (q >> 2) + 4 * hh) * 128 + 64 * vh + 32 * jn + r] = acc[q];
    __syncthreads();
}
__device__ __forceinline__ void p3_hgrn_scan(Frame& F, int tix, int ntx) {
    unsigned char* ws = F.ws;
    const float* DS = (const float*)(ws + WS_DS);
    const float* EV = (const float*)(ws + WS_EV);
    bf16* ST = (bf16*)(ws + WS_ST);
    for (int gi = tix; gi < 32 * 4096; gi += ntx) {
        const int bh = gi >> 12, q = gi & 4095, v = q >> 5, d0 = (q & 31) * 4;
        f32x4 S = (f32x4){0.f, 0.f, 0.f, 0.f};
#pragma unroll 8
        for (int c = 0; c < 32; ++c) {
            const size_t item = (size_t)bh * 32 + c;
            const f32x4 e4 = *(const GAS f32x4*)(EV + item * 128 + d0);
            const f32x4 ds = *(const GAS f32x4*)(DS + item * 16384 + v * 128 + d0);
            v2u o; o.x = pk2(S.x, S.y); o.y = pk2(S.z, S.w);
            *(GAS v2u*)(ST + item * 16384 + v * 128 + d0) = o;
            S = e4 * S + ds;
        }
        float* outp = F.out + O_PHG + (size_t)bh * 16384;
        outp[(size_t)(d0 + 0) * 128 + v] = S.x; outp[(size_t)(d0 + 1) * 128 + v] = S.y; outp[(size_t)(d0 + 2) * 128 + v] = S.z; outp[(size_t)(d0 + 3) * 128 + v] = S.w;
    }
}
__device__ __forceinline__ void p3_sample_item(Frame& F, int it) {
    unsigned char* ws = F.ws;
    const int type = it >> 9, bh = it & 511, b = bh >> 2, h = bh & 3;
    int tid = F.tid; asm volatile("" : "+v"(tid));
    const int v = tid & 127, dg = tid >> 7;
    LAS float* FQ = (LAS float*)(F.lds);
    LAS float* FK = FQ + 512;
    LAS float* FF_ = FK + 512;
    LAS float* FV = FF_ + 512;
    LAS float* FG = FV + 512;
    LAS float* RED = FG + 512;
    LAS float* RO = RED + 1024;
    LAS float* SS = RO + 2048;
    const bf16* PROJ = (const bf16*)(ws + WS_PROJ);
    const float* GBA = (const float*)(ws + WS_GBA);
    bf16* MIX = (bf16*)(ws + WS_MIX);
    const int t_ = tid >> 7, d_ = tid & 127;
    const size_t mrow = (size_t)MP + b * 4 + t_;
    if (type == 0) {
        const int ch = h * 128 + d_;
        const float l0 = F.in[9][ch], l1 = F.in[9][512 + ch];
        const float lb = 1.0f / (1.0f + __expf(l1 - l0));
        const bf16* pr = PROJ + mrow * PC + ch;
        const float hq = bf2f(pr[0]), hf = bf2f(pr[512]), hi = bf2f(pr[1024]), hg = bf2f(pr[1536]);
        const float kk = (1.0f - lb) / (1.0f + __expf(hf));
        FQ[tid] = siluf(hq); FK[tid] = kk; FF_[tid] = 1.0f - kk; FV[tid] = hi; FG[tid] = hg;
    } else {
        const float* cbuf = F.in[4] + (size_t)b * 3 * 1536;
        const float* wconv = F.in[11];
        float y[3];
#pragma unroll
        for (int seg = 0; seg < 3; ++seg) { const int ch = seg * 512 + h * 128 + d_; float a = 0.f;
#pragma unroll
            for (int tap = 0; tap < 4; ++tap) { const int rr = t_ + tap;
                const float xv = rr < 3 ? cbuf[rr * 1536 + ch] : bf2f(PROJ[((size_t)MP + b * 4 + (rr - 3)) * PC + 2048 + ch]);
                a += xv * wconv[tap * 1536 + ch]; }
            y[seg] = siluf(a); }
        float sq = wave_sum(y[0] * y[0]), sk = wave_sum(y[1] * y[1]);
        if ((tid & 63) == 0) { SS[(tid >> 6) * 2] = sq; SS[(tid >> 6) * 2 + 1] = sk; }
        __syncthreads();
        const float tq = SS[(t_ * 2) * 2] + SS[(t_ * 2 + 1) * 2], tk = SS[(t_ * 2) * 2 + 1] + SS[(t_ * 2 + 1) * 2 + 1];
        FQ[tid] = y[0] * rsqrtf(tq + RMS_EPS) * 0.08838834764831845f; FK[tid] = y[1] * rsqrtf(tk + RMS_EPS); FV[tid] = y[2];
        FG[tid] = bf2f(PROJ[mrow * PC + 3584 + h * 128 + d_]);
        if (tid < 4) { const float gb = GBA[((size_t)MP + b * 4 + tid) * 8 + h], ga = GBA[((size_t)MP + b * 4 + tid) * 8 + 4 + h];
            const float x = ga + F.in[13][h]; const float sp = x > 20.f ? x : log1pf(__expf(x));
            SS[16 + tid] = sigm(gb); SS[20 + tid] = __expf(-__expf(F.in[12][h]) * sp); }
    }
    __syncthreads();
    const float* sin0 = opq(F.in[2]); const float* sin1 = opq(F.in[3]);
    const float* S0 = (type == 0 ? sin0 : sin1) + (size_t)bh * 16384 + (size_t)(dg * 32) * 128 + v;
    float* S1 = F.out + (type == 0 ? O_SHG : O_SGD) + (size_t)bh * 16384 + (size_t)(dg * 32) * 128 + v;
    float S[32];
#pragma unroll
    for (int i = 0; i < 32; ++i) S[i] = S0[(size_t)i * 128];
    if (type == 0) {
#pragma unroll
        for (int t = 0; t < 4; ++t) { const float vt = FV[t * 128 + v]; float po = 0.f;
#pragma unroll
            for (int i = 0; i < 32; ++i) { const int d = dg * 32 + i; S[i] = FF_[t * 128 + d] * S[i] + FK[t * 128 + d] * vt; po += FQ[t * 128 + d] * S[i]; }
            RO[(t * 4 + dg) * 128 + v] = po; }
    } else {
#pragma unroll
        for (int t = 0; t < 4; ++t) { const float vt = FV[t * 128 + v], bt = SS[16 + t], at = SS[20 + t]; float pk = 0.f;
#pragma unroll
            for (int i = 0; i < 32; ++i) pk += FK[t * 128 + dg * 32 + i] * S[i];
            LAS float* rd = RED + (t & 1) * 512; rd[dg * 128 + v] = pk;
            __syncthreads();
            const float ks = (rd[v] + rd[128 + v]) + (rd[256 + v] + rd[384 + v]);
            const float u = bt * (vt - at * ks); float po = 0.f;
#pragma unroll
            for (int i = 0; i < 32; ++i) { const int d = dg * 32 + i; S[i] = at * S[i] + FK[t * 128 + d] * u; po += FQ[t * 128 + d] * S[i]; }
            RO[(t * 4 + dg) * 128 + v] = po; }
    }
#pragma unroll
    for (int i = 0; i < 32; ++i) S1[(size_t)i * 128] = S[i];
    __syncthreads();
    {
        const float o = (RO[(t_ * 4 + 0) * 128 + d_] + RO[(t_ * 4 + 1) * 128 + d_]) + (RO[(t_ * 4 + 2) * 128 + d_] + RO[(t_ * 4 + 3) * 128 + d_]);
        const float sq = wave_sum(o * o);
        if ((tid & 63) == 0) SS[8 + (tid >> 6)] = sq;
        __syncthreads();
        const float tot = SS[8 + t_ * 2] + SS[8 + t_ * 2 + 1];
        const float* ng0 = opq(F.in[14]); const float* ng1 = opq(F.in[15]);
        const float gsc = (type == 0 ? ng0 : ng1)[d_];
        const float y = o * rsqrtf(tot * (1.0f / 128.0f) + RMS_EPS) * gsc * siluf(FG[tid]);
        MIX[mrow * D + type * 512 + h * 128 + d_] = (bf16)f2bf(y);
    }
    __syncthreads();
}
__device__ __forceinline__ void p3_phase(Frame& F) {
    const int G = F.G, NG = G >= 128 ? 64 : (G >= 2 ? G / 2 : 0);
    if ((int)blockIdx.x < NG) { for (int wi = blockIdx.x; wi < 64; wi += NG) p3_gdn_scan(F, wi); }
    else {
        const int nb = G - NG, bx = blockIdx.x - NG;
        p3_hgrn_scan(F, bx * NT + F.tid, nb * NT);
        for (int it = bx; it < 1024; it += nb) p3_sample_item(F, it);
    }
    if (NG == 0) { for (int wi = 0; wi < 64; ++wi) p3_gdn_scan(F, wi); }
}

__device__ __forceinline__ void p4_item(Frame& F, int item) {
    unsigned char* ws = F.ws;
    const int type = item >> 10, j = item & 1023, b = j >> 7, h = (j >> 5) & 3, c = j & 31;
    const int R0 = b * 2048 + c * 64;
    LAS bf16* QXs = (LAS bf16*)(F.lds);
    LAS bf16* STs = (LAS bf16*)(F.lds + 17408);
    LAS float* RED = (LAS float*)(F.lds + 52224);
    const bf16* QXg = (const bf16*)(ws + WS_QX) + (size_t)item * 8192;
    const bf16* O0g = (const bf16*)(ws + WS_O0) + (size_t)item * 8192;
    const bf16* STg = (const bf16*)(ws + WS_ST) + (size_t)item * 16384;
    const bf16* PROJ = (const bf16*)(ws + WS_PROJ);
    bf16* MIX = (bf16*)(ws + WS_MIX);
    int tid = F.tid; asm volatile("" : "+v"(tid));
    const int lane = tid & 63, w = F.wave;
#pragma unroll
    for (int u = 0; u < 2; ++u) { const int q = tid + NT * u, row = q >> 4, ck = q & 15; *(LAS v4u*)(QXs + row * 136 + ck * 8) = *(const GAS v4u*)(QXg + row * 128 + ck * 8); }
#pragma unroll
    for (int u = 0; u < 4; ++u) { const int q = tid + NT * u, row = q >> 4, ck = q & 15; *(LAS v4u*)(STs + row * 136 + ck * 8) = *(const GAS v4u*)(STg + row * 128 + ck * 8); }
    __syncthreads();
    const int fr = lane & 15, fq = lane >> 4, i = w & 3, half = w >> 2, n0 = 64 * half;
    f32x4 acc[1][4]; zero_acc(acc);
    mma_lds<1, 4>(acc, QXs + 16 * i * 136, 136, STs + n0 * 136, 136, 128, lane);
    const int t = 16 * i + fr;
    float ss = 0.f;
#pragma unroll
    for (int jn = 0; jn < 4; ++jn) { const int v0 = n0 + 16 * jn + 4 * fq; const v2u o0 = *(const GAS v2u*)(O0g + t * 128 + v0);
        acc[0][jn][0] += bflo(o0.x); acc[0][jn][1] += bfhi(o0.x); acc[0][jn][2] += bflo(o0.y); acc[0][jn][3] += bfhi(o0.y);
        ss += acc[0][jn][0] * acc[0][jn][0] + acc[0][jn][1] * acc[0][jn][1] + acc[0][jn][2] * acc[0][jn][2] + acc[0][jn][3] * acc[0][jn][3]; }
    ss += __shfl_xor(ss, 16); ss += __shfl_xor(ss, 32);
    if (fq == 0) RED[t * 2 + half] = ss;
    __syncthreads();
    const float rinv = rsqrtf((RED[t * 2] + RED[t * 2 + 1]) * (1.0f / 128.0f) + RMS_EPS);
    const float* ng0 = opq(F.in[14]); const float* ng1 = opq(F.in[15]);
    const float* gsc = type == 0 ? ng0 : ng1;
    const bf16* gp = PROJ + (size_t)(R0 + t) * PC + (type == 0 ? 1536 : 3584) + h * 128;
    bf16* mp = MIX + (size_t)(R0 + t) * D + type * 512 + h * 128;
#pragma unroll
    for (int jn = 0; jn < 4; ++jn) { const int v0 = n0 + 16 * jn + 4 * fq; const v2u gz = *(const GAS v2u*)(gp + v0); const f32x4 gg = *(const f32x4*)(gsc + v0);
        v2u o; o.x = pk2(acc[0][jn][0] * rinv * gg.x * siluf(bflo(gz.x)), acc[0][jn][1] * rinv * gg.y * siluf(bfhi(gz.x)));
        o.y = pk2(acc[0][jn][2] * rinv * gg.z * siluf(bflo(gz.y)), acc[0][jn][3] * rinv * gg.w * siluf(bfhi(gz.y)));
        *(GAS v2u*)(mp + v0) = o; }
    __syncthreads();
}

__device__ __forceinline__ void ln_rows(Frame& F, const float* Y, const float* g, const float* bta, float* of0, float* of1, int split, bf16* ob) {
    const int gw = blockIdx.x * NWAVES + F.wave, NGW = F.G * NWAVES, lane = F.lane;
    f32x4 gg[4], bb[4];
#pragma unroll
    for (int j = 0; j < 4; ++j) { gg[j] = *(const f32x4*)(g + 256 * j + 4 * lane); bb[j] = *(const f32x4*)(bta + 256 * j + 4 * lane); }
    for (int row = gw; row < M; row += NGW) {
        const GAS f32x4* xr = (const GAS f32x4*)(Y + (size_t)row * D) + lane;
        f32x4 v[4]; float s = 0.f;
#pragma unroll
        for (int j = 0; j < 4; ++j) { v[j] = xr[64 * j]; s += (v[j].x + v[j].y) + (v[j].z + v[j].w); }
        const float mean = wave_sum(s) * (1.f / D); float s2 = 0.f;
#pragma unroll
        for (int j = 0; j < 4; ++j) { v[j] = v[j] - mean; s2 += (v[j].x * v[j].x + v[j].y * v[j].y) + (v[j].z * v[j].z + v[j].w * v[j].w); }
        const float rstd = rsqrtf(wave_sum(s2) * (1.f / D) + LN_EPS);
        float* of = of0 ? (row < split ? of0 + (size_t)row * D : of1 + (size_t)(row - split) * D) : nullptr;
#pragma unroll
        for (int j = 0; j < 4; ++j) { const f32x4 y = v[j] * rstd * gg[j] + bb[j];
            if (of) *(GAS f32x4*)(of + 256 * j + 4 * lane) = y;
            if (ob) { v2u w; w.x = pk2(y.x, y.y); w.y = pk2(y.z, y.w); *(GAS v2u*)(ob + (size_t)row * D + 256 * j + 4 * lane) = w; } }
    }
}

__device__ __forceinline__ void p8_item(Frame& F, int item) {
    unsigned char* ws = F.ws;
    LAS bf16* KV = (LAS bf16*)(F.lds);
    LAS bf16* PB = (LAS bf16*)(F.lds + 69632) + F.wave * (16 * 264);
    const bf16* QB = (const bf16*)(ws + WS_QB);
    bf16* OB = (bf16*)(ws + WS_OB);
    int tid = F.tid; asm volatile("" : "+v"(tid));
    const int lane = tid & 63, w = F.wave, fr = lane & 15, fq = lane >> 4;
    const bool samp = item >= 512;
    int b, h, row0, nvalid;
    if (!samp) { b = item >> 6; h = (item >> 4) & 3; row0 = b * 2048 + (item & 15) * 128 + 16 * w; nvalid = 16; }
    else { const int bh = item - 512; b = bh >> 2; h = bh & 3; row0 = MP + b * 4; nvalid = (w == 0) ? 4 : 0; }
    const bool active = nvalid > 0;
    const int qrow = row0 + (fr < nvalid ? fr : 0);
    f32x4 sacc[16];
#pragma unroll
    for (int jn = 0; jn < 16; ++jn) sacc[jn] = (f32x4){0.f, 0.f, 0.f, 0.f};
    for (int hf = 0; hf < 2; ++hf) {
        if (!samp) { const bf16* src = (const bf16*)(ws + WS_MKB) + (size_t)(b * 256) * 1024 + h * 256 + hf * 128;
#pragma unroll
            for (int u = 0; u < 8; ++u) { const int q = tid + NT * u, m = q >> 4, ck = q & 15; *(LAS v4u*)(KV + m * 136 + ck * 8) = *(const GAS v4u*)(src + (size_t)m * 1024 + ck * 8); }
        } else { const float* src = F.in[6] + (size_t)(b * 256) * 1024 + h * 256 + hf * 128;
#pragma unroll 4
            for (int u = 0; u < 16; ++u) { const int q = tid + NT * u, m = q >> 5, ck = q & 31; const f32x4 x = *(const GAS f32x4*)(src + (size_t)m * 1024 + ck * 4);
                v2u o; o.x = pk2(x.x, x.y); o.y = pk2(x.z, x.w); *(LAS v2u*)(KV + m * 136 + ck * 4) = o; }
        }
        __syncthreads();
        if (active) {
            for (int k0 = 0; k0 < 128; k0 += 32) {
                bf16x8 a = *(const GAS bf16x8*)(QB + (size_t)qrow * D + h * 256 + hf * 128 + k0 + 8 * fq);
                if (fr >= nvalid) a = (bf16x8){0, 0, 0, 0, 0, 0, 0, 0};
#pragma unroll
                for (int jn = 0; jn < 16; ++jn) { const bf16x8 bb = *(const LAS bf16x8*)(KV + (16 * jn + fr) * 136 + k0 + 8 * fq); sacc[jn] = __builtin_amdgcn_mfma_f32_16x16x32_bf16(bb, a, sacc[jn], 0, 0, 0); }
            }
        }
        __syncthreads();
    }
    if (active) {
        float mx = -3.0e38f;
#pragma unroll
        for (int jn = 0; jn < 16; ++jn) { sacc[jn] = sacc[jn] * 0.0625f; mx = fmaxf(mx, fmaxf(fmaxf(sacc[jn][0], sacc[jn][1]), fmaxf(sacc[jn][2], sacc[jn][3]))); }
        mx = fmaxf(mx, __shfl_xor(mx, 16)); mx = fmaxf(mx, __shfl_xor(mx, 32));
        float sum = 0.f;
#pragma unroll
        for (int jn = 0; jn < 16; ++jn) {
#pragma unroll
            for (int e = 0; e < 4; ++e) { const float p = __expf(sacc[jn][e] - mx); sacc[jn][e] = p; sum += p; } }
        sum += __shfl_xor(sum, 16); sum += __shfl_xor(sum, 32);
        const float inv = 1.0f / sum;
#pragma unroll
        for (int jn = 0; jn < 16; ++jn) { v2u o; o.x = pk2(sacc[jn][0] * inv, sacc[jn][1] * inv); o.y = pk2(sacc[jn][2] * inv, sacc[jn][3] * inv); *(LAS v2u*)(PB + fr * 264 + 16 * jn + 4 * fq) = o; }
    }
    for (int hf = 0; hf < 2; ++hf) {
        if (!samp) { const bf16* src = (const bf16*)(ws + WS_VTB) + (size_t)(h * 256 + hf * 128) * 2048 + b * 256;
#pragma unroll
            for (int u = 0; u < 8; ++u) { const int q = tid + NT * u, d = q >> 5, ck = q & 31; *(LAS v4u*)(KV + d * 264 + ck * 8) = *(const GAS v4u*)(src + (size_t)d * 2048 + ck * 8); }
        } else { const float* src = F.in[7] + (size_t)(b * 256) * 1024 + h * 256 + hf * 128;
#pragma unroll 4
            for (int u = 0; u < 16; ++u) { const int q = tid + NT * u, m = q >> 5, ck = q & 31; const f32x4 x = *(const GAS f32x4*)(src + (size_t)m * 1024 + ck * 4);
                KV[(ck * 4 + 0) * 264 + m] = (bf16)f2bf(x.x); KV[(ck * 4 + 1) * 264 + m] = (bf16)f2bf(x.y); KV[(ck * 4 + 2) * 264 + m] = (bf16)f2bf(x.z); KV[(ck * 4 + 3) * 264 + m] = (bf16)f2bf(x.w); }
        }
        __syncthreads();
        if (active) {
            f32x4 oacc[8];
#pragma unroll
            for (int jn = 0; jn < 8; ++jn) oacc[jn] = (f32x4){0.f, 0.f, 0.f, 0.f};
            for (int k0 = 0; k0 < 256; k0 += 32) {
                const bf16x8 a = *(const LAS bf16x8*)(PB + fr * 264 + k0 + 8 * fq);
#pragma unroll
                for (int jn = 0; jn < 8; ++jn) { const bf16x8 bb = *(const LAS bf16x8*)(KV + (16 * jn + fr) * 264 + k0 + 8 * fq); oacc[jn] = __builtin_amdgcn_mfma_f32_16x16x32_bf16(bb, a, oacc[jn], 0, 0, 0); }
            }
            if (fr < nvalid) {
#pragma unroll
                for (int jn = 0; jn < 8; ++jn) { v2u o; o.x = pk2(oacc[jn][0], oacc[jn][1]); o.y = pk2(oacc[jn][2], oacc[jn][3]); *(GAS v2u*)(OB + (size_t)(row0 + fr) * D + h * 256 + hf * 128 + 16 * jn + 4 * fq) = o; }
            }
        }
        __syncthreads();
    }
}

__device__ __forceinline__ void p12_phase(Frame& F) {
    unsigned char* ws = F.ws;
    const bf16* UP = (const bf16*)(ws + WS_UP);
    bf16* ACT = (bf16*)(ws + WS_ACT);
    const float* wc = F.in[25]; const float* bc = F.in[26];
    const int gt = blockIdx.x * NT + F.tid, NGT = F.G * NT;
    for (int i = gt; i < M * (FF / 8); i += NGT) {
        const int row = i / (FF / 8), f0 = (i % (FF / 8)) * 8;
        int t, b; const bool samp = row >= MP;
        if (!samp) { b = row >> 11; t = row & 2047; } else { b = (row - MP) >> 2; t = (row - MP) & 3; }
        const v4u g2 = *(const GAS v4u*)(UP + (size_t)row * UPC + f0);
        const v4u vv = *(const GAS v4u*)(UP + (size_t)row * UPC + FF + f0);
        float x0[8], x1[8], x2[8];
        x2[0] = bflo(g2.x); x2[1] = bfhi(g2.x); x2[2] = bflo(g2.y); x2[3] = bfhi(g2.y); x2[4] = bflo(g2.z); x2[5] = bfhi(g2.z); x2[6] = bflo(g2.w); x2[7] = bfhi(g2.w);
        if (t >= 1) { const v4u g1 = *(const GAS v4u*)(UP + (size_t)(row - 1) * UPC + f0);
            x1[0] = bflo(g1.x); x1[1] = bfhi(g1.x); x1[2] = bflo(g1.y); x1[3] = bfhi(g1.y); x1[4] = bflo(g1.z); x1[5] = bfhi(g1.z); x1[6] = bflo(g1.w); x1[7] = bfhi(g1.w);
        } else if (samp) { const float* bp = F.in[5] + ((size_t)b * 2 + 1) * FF + f0;
#pragma unroll
            for (int e = 0; e < 8; ++e) x1[e] = bp[e];
        } else {
#pragma unroll
            for (int e = 0; e < 8; ++e) x1[e] = 0.f; }
        if (t >= 2) { const v4u g0 = *(const GAS v4u*)(UP + (size_t)(row - 2) * UPC + f0);
            x0[0] = bflo(g0.x); x0[1] = bfhi(g0.x); x0[2] = bflo(g0.y); x0[3] = bfhi(g0.y); x0[4] = bflo(g0.z); x0[5] = bfhi(g0.z); x0[6] = bflo(g0.w); x0[7] = bfhi(g0.w);
        } else if (samp) { const float* bp = F.in[5] + ((size_t)b * 2 + t) * FF + f0;
#pragma unroll
            for (int e = 0; e < 8; ++e) x0[e] = bp[e];
        } else {
#pragma unroll
            for (int e = 0; e < 8; ++e) x0[e] = 0.f; }
        float val[8];
        val[0] = bflo(vv.x); val[1] = bfhi(vv.x); val[2] = bflo(vv.y); val[3] = bfhi(vv.y); val[4] = bflo(vv.z); val[5] = bfhi(vv.z); val[6] = bflo(vv.w); val[7] = bfhi(vv.w);
        float r[8];
#pragma unroll
        for (int e = 0; e < 8; e += 2) {
            pg8::f32x2 z; z.x = wc[f0 + e] * x0[e] + wc[FF + f0 + e] * x1[e] + wc[2 * FF + f0 + e] * x2[e] + bc[f0 + e];
            z.y = wc[f0 + e + 1] * x0[e + 1] + wc[FF + f0 + e + 1] * x1[e + 1] + wc[2 * FF + f0 + e + 1] * x2[e + 1] + bc[f0 + e + 1];
            const pg8::f32x2 gl = pg8::gelu_pk(z); r[e] = gl.x * val[e]; r[e + 1] = gl.y * val[e + 1]; }
        *(GAS v4u*)(ACT + (size_t)row * FF + f0) = (v4u){pk2(r[0], r[1]), pk2(r[2], r[3]), pk2(r[4], r[5]), pk2(r[6], r[7])};
    }
    for (int i = gt; i < 8 * 2 * FF; i += NGT) { const int f = i % FF, jr = (i / FF) & 1, b = i / (2 * FF); F.out[O_PFC + i] = bf2f(UP[(size_t)(b * 2048 + 2046 + jr) * UPC + f]); }
    for (int i = gt; i < 128 * 2 * FF; i += NGT) { const int f = i % FF, jr = (i / FF) & 1, b = i / (2 * FF); F.out[O_SFC + i] = bf2f(UP[(size_t)(MP + b * 4 + 2 + jr) * UPC + f]); }
}

#ifndef MK_N_LAUNCHES
#define MK_N_LAUNCHES 1
#endif
constexpr int N_PHASES = 15;
struct Args { const float* in[30]; float* out; unsigned char* ws; int ph_lo, ph_hi; };
__global__ void __launch_bounds__(NT, 2) fwd_megakernel(Args args) {
    extern __shared__ __attribute__((aligned(16))) unsigned char lds[];
    Frame F;
    F.lds = (LAS unsigned char*)lds;
    F.MISC = (volatile LAS unsigned*)(F.lds + MISC_OFF);
    F.tid = threadIdx.x; F.lane = F.tid & 63; F.wave = __builtin_amdgcn_readfirstlane(F.tid >> 6);
    F.G = gridDim.x;
#pragma unroll
    for (int i = 0; i < 30; ++i) F.in[i] = args.in[i];
    F.out = args.out; F.ws = args.ws;
    F.ctl = (gu32*)(args.ws + WS_CTL);
    for (int u = F.tid; u < (LDS_BYTES - MISC_OFF) / 4; u += NT) ((LAS unsigned*)(F.lds + MISC_OFF))[u] = 0u;
    __syncthreads();
    XcdBarrier bar; bar.bar = (unsigned*)(F.ctl + CW_BAR); bar.x = 0; bar.st = nullptr;
    if (MK_N_LAUNCHES == 1) bar = xcd_barrier_post((unsigned*)(F.ctl + CW_BAR), F.MISC + 8);
    const int lo = args.ph_lo, hi = args.ph_hi;
#ifndef MK_MASK
#define MK_MASK 0x7fff
#endif
#define IN(k) ((((MK_MASK) >> (k)) & 1) && lo <= (k) && (k) < hi)
#define SEAM(k) do { if (IN(k) && IN((k) + 1)) xcd_barrier(bar); } while (0)
    unsigned char* ws = args.ws;
    bf16* BIG = (bf16*)(ws + WS_BIG);

    if (IN(0)) { p0_prologue(F); } SEAM(0);
    if (IN(1)) {
        pg8::Gemm g{BIG, BIG, 0, 0, D}; OrderP1 S; S.init(F.G, (int)blockIdx.x);
        EpiP1 E{(bf16*)(ws + WS_PROJ), F.out + O_PMK, F.out + O_PMV, (bf16*)(ws + WS_MKB), (bf16*)(ws + WS_VTB)};
        pg8::gemm_phase<EpiP1, OrderP1, true, true>(F.lds, g, S, E);
    } SEAM(1);
    if (IN(2)) { p2_phase(F); } SEAM(2);
    if (IN(3)) { p3_phase(F); } SEAM(3);
    if (IN(4)) { for (int it = blockIdx.x; it < 2048; it += F.G) p4_item(F, it); } SEAM(4);
    if (IN(5)) {
        pg8::Gemm g{(const bf16*)(ws + WS_MIX), (const bf16*)(ws + WS_WOUT), M, D, D}; pg8::StaticOrder S; S.init(M, D, F.G, (int)blockIdx.x);
        EpiRes E{F.in[0], F.in[1], MP, (float*)(ws + WS_Y)};
        pg8::gemm_phase<EpiRes, pg8::StaticOrder, true, true>(F.lds, g, S, E);
    } SEAM(5);
    if (IN(6)) { ln_rows(F, (const float*)(ws + WS_Y), F.in[17], F.in[18], (float*)(ws + WS_H1F), (float*)(ws + WS_H1F), M, (bf16*)(ws + WS_H1B)); } SEAM(6);
    if (IN(7)) {
        pg8::Gemm g{(const bf16*)(ws + WS_H1B), (const bf16*)(ws + WS_WMQ), M, D, D}; pg8::StaticOrder S; S.init(M, D, F.G, (int)blockIdx.x);
        pg8::EpiBf16<0> E{(bf16*)(ws + WS_QB), D, nullptr, 0, 0, 1.f};
        pg8::gemm_phase<pg8::EpiBf16<0>, pg8::StaticOrder, true, true>(F.lds, g, S, E);
    } SEAM(7);
    if (IN(8)) { for (int it = blockIdx.x; it < 1024; it += F.G) p8_item(F, it); } SEAM(8);
    if (IN(9)) {
        pg8::Gemm g{(const bf16*)(ws + WS_OB), (const bf16*)(ws + WS_WMO), M, D, D}; pg8::StaticOrder S; S.init(M, D, F.G, (int)blockIdx.x);
        EpiRes E{(const float*)(ws + WS_H1F), (const float*)(ws + WS_H1F), M, (float*)(ws + WS_Y)};
        pg8::gemm_phase<EpiRes, pg8::StaticOrder, true, true>(F.lds, g, S, E);
    } SEAM(9);
    if (IN(10)) { ln_rows(F, (const float*)(ws + WS_Y), F.in[22], F.in[23], (float*)(ws + WS_H2F), (float*)(ws + WS_H2F), M, (bf16*)(ws + WS_H2B)); } SEAM(10);
    if (IN(11)) {
        pg8::Gemm g{(const bf16*)(ws + WS_H2B), (const bf16*)(ws + WS_WUP), M, UPC, D}; pg8::StaticOrder S; S.init(M, UPC, F.G, (int)blockIdx.x);
        pg8::EpiBf16<0> E{(bf16*)(ws + WS_UP), UPC, nullptr, 0, 0, 1.f};
        pg8::gemm_phase<pg8::EpiBf16<0>, pg8::StaticOrder, true, true>(F.lds, g, S, E);
    } SEAM(11);
    if (IN(12)) { p12_phase(F); } SEAM(12);
    if (IN(13)) {
        pg8::Gemm g{(const bf16*)(ws + WS_ACT), (const bf16*)(ws + WS_WDN), M, D, FF}; pg8::StaticOrder S; S.init(M, D, F.G, (int)blockIdx.x);
        EpiRes E{(const float*)(ws + WS_H2F), (const float*)(ws + WS_H2F), M, (float*)(ws + WS_Y)};
        pg8::gemm_phase<EpiRes, pg8::StaticOrder, true, true>(F.lds, g, S, E);
    } SEAM(13);
    if (IN(14)) { ln_rows(F, (const float*)(ws + WS_Y), F.in[28], F.in[29], F.out + O_YP, F.out + O_YS, MP, nullptr); }
#undef IN
#undef SEAM
}

extern "C" void kernel_launch(void* const* d_in, const int* in_sizes, int n_in, void* d_out, int out_size, void* d_ws, size_t ws_size, hipStream_t stream) {
    static int grid = 0;
    if (grid == 0) {
        if (n_in != 30 || out_size != 40714240 || ws_size < WS_NEED) { fprintf(stderr, "kernel_launch: unexpected problem (n_in %d, out %d, ws %zu); nothing launched\n", n_in, out_size, ws_size); grid = -1; return; }
        int dev = 0, cus = 0, per_cu = 0;
        if (hipGetDevice(&dev) != hipSuccess || hipDeviceGetAttribute(&cus, hipDeviceAttributeMultiprocessorCount, dev) != hipSuccess) { grid = -1; return; }
        if (hipFuncSetAttribute((const void*)fwd_megakernel, hipFuncAttributeMaxDynamicSharedMemorySize, LDS_BYTES) != hipSuccess) { fprintf(stderr, "kernel_launch: hipFuncSetAttribute failed\n"); grid = -1; return; }
        if (hipOccupancyMaxActiveBlocksPerMultiprocessor(&per_cu, (const void*)fwd_megakernel, NT, LDS_BYTES) != hipSuccess || per_cu < 1) { fprintf(stderr, "kernel_launch: occupancy query says %d blocks per CU\n", per_cu); per_cu = 1; }
        (void)hipGetLastError();
        grid = cus;
    }
    if (grid < 0) return;
    (void)hipMemsetAsync((char*)d_ws + WS_CTL, 0, CTL_ZERO_BYTES, stream);
    Args a{};
    for (int i = 0; i < 30; ++i) a.in[i] = (const float*)d_in[i];
    a.out = (float*)d_out; a.ws = (unsigned char*)d_ws;
    if (MK_N_LAUNCHES == 1) {
        a.ph_lo = 0; a.ph_hi = MK_PH_HI;
        void* kargs[] = {&a};
        hipError_t e = hipLaunchCooperativeKernel((const void*)fwd_megakernel, dim3(grid), dim3(NT), kargs, LDS_BYTES, stream);
        if (e != hipSuccess) { fprintf(stderr, "kernel_launch: cooperative launch failed: %s (grid %d)\n", hipGetErrorString(e), grid); }
    } else {
        for (int li = 0; li < N_PHASES && li < MK_PH_HI; ++li) { a.ph_lo = li; a.ph_hi = li + 1; hipLaunchKernelGGL(fwd_megakernel, dim3(grid), dim3(NT), LDS_BYTES, stream, a); }
    }
}
```
